# Optimizing an MI355X kernel written in HIP

```python
import jax, jax.numpy as jnp
from jax import lax

D_MODEL = 2048
BATCH = 4
SEQ = 2048
DEPTH = 1
DEC_BATCH = 128
DEC_SEQ = 1
PAST_LEN = 16384
PAGE_SIZE = 128

D_MIX = D_MODEL
D_GDN = D_MIX // 2
D_POOL = D_MIX - D_GDN
GDN_HEAD_DIM = 128
GDN_HEADS = D_GDN // GDN_HEAD_DIM
D_QKV = 3 * D_GDN
CONV_W = 4
CHUNK = 64
POOL_WINDOWS = (2, 4, 8, 16)
POOL_GROUPS = len(POOL_WINDOWS)
POOL_GROUP_DIM = D_POOL // POOL_GROUPS
POOL_BUF = max(POOL_WINDOWS) - 1
D_FF = 4 * D_MODEL
N_IN = D_QKV + D_GDN + 2 * GDN_HEADS + D_POOL
EPS = 1e-6

kernel_name = "hymba_gdn_pool_sandwich_decode"


def _rmsnorm(x, w):
    xf = x.astype(jnp.float32)
    y = xf * lax.rsqrt(jnp.mean(xf * xf, axis=-1, keepdims=True) + EPS)
    return (y * w.astype(jnp.float32)).astype(x.dtype)


def _l2norm(x):
    return x * lax.rsqrt(jnp.sum(x * x, axis=-1, keepdims=True) + EPS)


def _gdn_chunked(q, k, v, g, beta, s0):
    B, L, H, DK = q.shape
    DV = v.shape[-1]
    nc = L // CHUNK
    to_c = lambda t: t.reshape(B, nc, CHUNK, H, -1).transpose(0, 3, 1, 2, 4)
    q, k, v = to_c(q), to_c(k), to_c(v)
    g = g.reshape(B, nc, CHUNK, H).transpose(0, 3, 1, 2)
    beta = beta.reshape(B, nc, CHUNK, H).transpose(0, 3, 1, 2)
    gc = jnp.cumsum(g, axis=-1)
    tril = jnp.tril(jnp.ones((CHUNK, CHUNK), bool))
    strict = jnp.tril(jnp.ones((CHUNK, CHUNK), bool), -1)
    decay = jnp.exp(jnp.where(tril, gc[..., :, None] - gc[..., None, :], -jnp.inf))
    kb = k * beta[..., None]
    lmat = jnp.where(strict, jnp.einsum('bhncd,bhnsd->bhncs', kb, k) * decay, 0.0)
    a_mat = lmat + jnp.eye(CHUNK, dtype=jnp.float32)
    rhs = jnp.concatenate([v * beta[..., None], kb * jnp.exp(gc)[..., None]], axis=-1)
    sol = lax.linalg.triangular_solve(a_mat, rhs, left_side=True, lower=True)
    u, w = sol[..., :DV], sol[..., DV:]
    intra = jnp.where(tril, jnp.einsum('bhncd,bhnsd->bhncs', q, k) * decay, 0.0)

    def step(s, inp):
        qi, ki, ui, wi, gci, ai = inp
        v_new = ui - jnp.einsum('bhcd,bhde->bhce', wi, s)
        o = jnp.einsum('bhcd,bhde->bhce', qi * jnp.exp(gci)[..., None], s) + jnp.einsum('bhcs,bhse->bhce', ai, v_new)
        g_last = gci[..., -1]
        s = s * jnp.exp(g_last)[..., None, None] + jnp.einsum(
            'bhcd,bhce->bhde', ki * jnp.exp(g_last[..., None] - gci)[..., None], v_new)
        return s, o

    mv = lambda t: jnp.moveaxis(t, 2, 0)
    s_fin, o = lax.scan(step, s0, (mv(q), mv(k), mv(u), mv(w), mv(gc), mv(intra)))
    o = o.transpose(1, 0, 3, 2, 4).reshape(B, L, H, DV)
    return o, s_fin


def _gdn_recurrent(q, k, v, g, beta, s0):
    def step(s, inp):
        qt, kt, vt, gt, bt = inp
        s = s * jnp.exp(gt)[..., None, None]
        delta = (vt - jnp.einsum('bhd,bhde->bhe', kt, s)) * bt[..., None]
        s = s + kt[..., :, None] * delta[..., None, :]
        return s, jnp.einsum('bhd,bhde->bhe', qt, s)

    mv = lambda t: jnp.moveaxis(t, 1, 0)
    s_fin, o = lax.scan(step, s0, (mv(q), mv(k), mv(v), mv(g), mv(beta)))
    return jnp.moveaxis(o, 0, 1), s_fin


def _layer(x, pos0, conv_buf, pool_buf, s0, chunked, norm_pre_mix, w_in, conv_w, a_log, dt_bias,
           norm_gdn_out, w_pool, pool_scale, w_out, norm_post_mix, norm_pre_mlp, w_up, w_down, norm_post_mlp):
    B, L, _ = x.shape
    h = _rmsnorm(x, norm_pre_mix)
    proj = h @ w_in
    o1 = D_QKV; o2 = o1 + D_GDN; o3 = o2 + GDN_HEADS; o4 = o3 + GDN_HEADS
    qkv_in, gate, a_in, b_in, u = proj[..., :o1], proj[..., o1:o2], proj[..., o2:o3], proj[..., o3:o4], proj[..., o4:]

    xp = jnp.concatenate([conv_buf.astype(qkv_in.dtype), qkv_in], axis=1)
    conv = sum(conv_w[j] * xp[:, j:j + L] for j in range(CONV_W))
    new_conv = xp[:, -(CONV_W - 1):]
    qkv = jax.nn.silu(conv.astype(jnp.float32)).reshape(B, L, 3, GDN_HEADS, GDN_HEAD_DIM)
    q = _l2norm(qkv[:, :, 0]) * (GDN_HEAD_DIM ** -0.5)
    k = _l2norm(qkv[:, :, 1])
    v = qkv[:, :, 2]
    beta = jax.nn.sigmoid(b_in.astype(jnp.float32))
    g = -jnp.exp(a_log.astype(jnp.float32)) * jax.nn.softplus(a_in.astype(jnp.float32) + dt_bias.astype(jnp.float32))
    core = _gdn_chunked if chunked else _gdn_recurrent
    o_a, s_new = core(q, k, v, g, beta, s0.astype(jnp.float32))
    o_a = _rmsnorm(o_a, norm_gdn_out) * jax.nn.silu(gate.astype(jnp.float32)).reshape(B, L, GDN_HEADS, GDN_HEAD_DIM)
    o_a = o_a.reshape(B, L, D_GDN).astype(x.dtype)

    up = jnp.concatenate([pool_buf.astype(u.dtype), u], axis=1)
    upf = up.astype(jnp.float32)
    c0 = jnp.concatenate([jnp.zeros((B, 1, D_POOL), jnp.float32), jnp.cumsum(upf, axis=1)], axis=1)
    pos = pos0 + jnp.arange(L)
    cur = upf[:, POOL_BUF:]
    groups = []
    for i, win in enumerate(POOL_WINDOWS):
        sl = slice(i * POOL_GROUP_DIM, (i + 1) * POOL_GROUP_DIM)
        wsum = c0[:, POOL_BUF + 1:POOL_BUF + 1 + L, sl] - c0[:, POOL_BUF + 1 - win:POOL_BUF + 1 - win + L, sl]
        cnt = jnp.minimum(pos + 1, win).astype(jnp.float32)[None, :, None]
        groups.append(wsum / cnt - cur[..., sl])
    pooled = jnp.stack(groups, axis=2).astype(x.dtype)
    o_b = jnp.einsum('blgc,gcd->blgd', pooled, w_pool).reshape(B, L, D_POOL) * pool_scale
    new_pool = up[:, -POOL_BUF:]

    mix = jnp.concatenate([o_a, o_b.astype(x.dtype)], axis=-1) @ w_out
    x = x + _rmsnorm(mix, norm_post_mix)

    hm = _rmsnorm(x, norm_pre_mlp)
    ff = jnp.square(jax.nn.relu(hm @ w_up)) @ w_down
    x = x + _rmsnorm(ff, norm_post_mlp)
    return x, s_new.astype(x.dtype), new_conv, new_pool


def setup_inputs(seed: int = 0) -> dict:
    key = jax.random.key(seed)
    ks = jax.random.split(key, 20)
    f32 = jnp.float32
    nrm = lambda k, shape, scale: jax.random.normal(k, shape, f32) * scale
    gain = lambda k, n: 1.0 + 0.05 * jax.random.normal(k, (DEPTH, n), f32)
    return {
        "x_prompt": nrm(ks[0], (BATCH, SEQ, D_MODEL), 1.0),
        "x_sample": nrm(ks[1], (DEC_BATCH, DEC_SEQ, D_MODEL), 1.0),
        "state_gdn": nrm(ks[2], (DEPTH, DEC_BATCH, GDN_HEADS, GDN_HEAD_DIM, GDN_HEAD_DIM), 0.1),
        "state_conv": nrm(ks[3], (DEPTH, DEC_BATCH, CONV_W - 1, D_QKV), 1.0),
        "state_pool": nrm(ks[4], (DEPTH, DEC_BATCH, POOL_BUF, D_POOL), 1.0),
        "norm_pre_mix": gain(ks[5], D_MODEL),
        "w_in": nrm(ks[6], (DEPTH, D_MODEL, N_IN), D_MODEL ** -0.5),
        "conv_w": nrm(ks[7], (DEPTH, CONV_W, D_QKV), CONV_W ** -0.5),
        "a_log": jnp.log(jax.random.uniform(ks[8], (DEPTH, GDN_HEADS), f32, 1.0, 16.0)),
        "dt_bias": nrm(ks[9], (DEPTH, GDN_HEADS), 0.1),
        "norm_gdn_out": gain(ks[10], GDN_HEAD_DIM),
        "w_pool": nrm(ks[11], (DEPTH, POOL_GROUPS, POOL_GROUP_DIM, POOL_GROUP_DIM), POOL_GROUP_DIM ** -0.5),
        "pool_scale": 1.0 + 0.1 * jax.random.normal(ks[12], (DEPTH, D_POOL), f32),
        "w_out": nrm(ks[13], (DEPTH, D_MIX, D_MODEL), D_MIX ** -0.5),
        "norm_post_mix": gain(ks[14], D_MODEL),
        "norm_pre_mlp": gain(ks[15], D_MODEL),
        "w_up": nrm(ks[16], (DEPTH, D_MODEL, D_FF), D_MODEL ** -0.5),
        "w_down": nrm(ks[17], (DEPTH, D_FF, D_MODEL), D_FF ** -0.5),
        "norm_post_mlp": gain(ks[18], D_MODEL),
    }


def reference(x_prompt, x_sample, state_gdn, state_conv, state_pool, norm_pre_mix, w_in, conv_w, a_log,
              dt_bias, norm_gdn_out, w_pool, pool_scale, w_out, norm_post_mix, norm_pre_mlp, w_up, w_down,
              norm_post_mlp):
    yp, ys = x_prompt, x_sample
    gdn_p, conv_p, pool_p, gdn_s, conv_s, pool_s = [], [], [], [], [], []
    for l in range(DEPTH):
        params = (norm_pre_mix[l], w_in[l], conv_w[l], a_log[l], dt_bias[l], norm_gdn_out[l], w_pool[l],
                  pool_scale[l], w_out[l], norm_post_mix[l], norm_pre_mlp[l], w_up[l], w_down[l], norm_post_mlp[l])
        B = yp.shape[0]
        yp, s1, c1, p1 = _layer(
            yp, 0,
            jnp.zeros((B, CONV_W - 1, D_QKV), yp.dtype),
            jnp.zeros((B, POOL_BUF, D_POOL), yp.dtype),
            jnp.zeros((B, GDN_HEADS, GDN_HEAD_DIM, GDN_HEAD_DIM), jnp.float32),
            True, *params)
        ys, s2, c2, p2 = _layer(ys, PAST_LEN, state_conv[l], state_pool[l], state_gdn[l], False, *params)
        gdn_p.append(s1); conv_p.append(c1); pool_p.append(p1)
        gdn_s.append(s2); conv_s.append(c2); pool_s.append(p2)
    new_gdn_prompt = jnp.stack(gdn_p)
    new_conv_prompt = jnp.stack(conv_p)
    new_pool_prompt = jnp.stack(pool_p)
    new_gdn_sample = jnp.stack(gdn_s)
    new_conv_sample = jnp.stack(conv_s)
    new_pool_sample = jnp.stack(pool_s)
    return (yp, ys, new_gdn_prompt, new_conv_prompt, new_pool_prompt, new_gdn_sample, new_conv_sample, new_pool_sample)
```

```cpp
#include <hip/hip_runtime.h>
#include <hip/hip_cooperative_groups.h>
#include <cstdio>
#define DOUBLE_PHASE -1
namespace cg = cooperative_groups;

#define LAS __attribute__((address_space(3)))
typedef unsigned short bf16_t;
typedef short bf16x8 __attribute__((ext_vector_type(8)));
typedef float f32x4 __attribute__((ext_vector_type(4)));
typedef float f32x2 __attribute__((ext_vector_type(2)));
typedef unsigned u32x4 __attribute__((ext_vector_type(4)));
typedef unsigned u32x2 __attribute__((ext_vector_type(2)));

constexpr int DM = 2048, NBATCH = 4, SEQ = 2048, MP = NBATCH * SEQ, MS = 128, MT = MP + MS, MPAD = 8448;
constexpr int DQKV = 3072, NIN = 5136, NPROJ = 5120, NPADW = 5376, DFF = 8192;
constexpr int NCH = 1024;
constexpr float EPS = 1e-6f;

constexpr size_t OUT_Y = 0, OUT_GDN_P = 17039360, OUT_CONV_P = 17563648, OUT_POOL_P = 17600512, OUT_GDN_S = 17661952, OUT_CONV_S = 34439168, OUT_POOL_S = 35618816;

constexpr size_t WS_WUP = 0, WS_WDN = 33554432, WS_WIN = 67108864, WS_WOUT = 89128960, WS_WPOOL = 97517568, WS_AB = 98041856, WS_GL = 98582528,
                 WS_H = 98648064, WS_PROJ = 133251072, WS_GDN = 219758592;
constexpr size_t WS_W = WS_GDN, WS_QG = WS_W + 16777216, WS_KDT = WS_QG + 16777216, WS_INTRA = WS_KDT + 16777216, WS_U = WS_INTRA + 8388608, WS_GDN_END = WS_U + 33554432;
constexpr size_t WS_BAR = WS_GL + 8192;
constexpr size_t WS_SS = WS_GDN_END;
constexpr int KS5 = 8, KS8 = 16, KS7 = 4;
constexpr size_t WS_PART5 = WS_GDN;
constexpr size_t WS_PART8 = WS_H;
constexpr size_t WS_POOLED = WS_WIN;
constexpr size_t WS_MIX = WS_PROJ;
constexpr size_t WS_FF1 = WS_PROJ;
constexpr size_t WS_FF = WS_FF1 + (size_t)MPAD * DFF * 2;
constexpr size_t WS_PART7 = WS_FF;
constexpr size_t WS_X1 = WS_FF + (size_t)MP * DM * 2;
constexpr size_t WS_END = WS_X1 + (size_t)MT * DM * 2;
static_assert(WS_GDN_END <= WS_END && WS_FF >= WS_GDN_END - 50000000, "layout");

constexpr int LDS_BYTES = 147456;

struct Args { const float* in[19]; float* out; unsigned char* ws; };

typedef __bf16 bf16x2v __attribute__((ext_vector_type(2)));
__device__ __forceinline__ unsigned cvt_pk_bf16(float lo, float hi) { const f32x2 v = {lo, hi}; const bf16x2v r = __builtin_convertvector(v, bf16x2v); return __builtin_bit_cast(unsigned, r); }
__device__ __forceinline__ int otid() { int t = threadIdx.x; asm volatile("" : "+v"(t)); return t; }
__device__ __forceinline__ float bf_lo(unsigned u) { return __uint_as_float(u << 16); }
__device__ __forceinline__ float bf_hi(unsigned u) { return __uint_as_float(u & 0xffff0000u); }
__device__ __forceinline__ float bf1(bf16_t v) { return __uint_as_float(((unsigned)v) << 16); }
__device__ __forceinline__ float wave_sum(float v) {
#pragma unroll
    for (int o = 32; o >= 1; o >>= 1) v += __shfl_xor(v, o);
    return v;
}
__device__ __forceinline__ float silu_f(float x) { return x * __builtin_amdgcn_rcpf(1.0f + __expf(-x)); }
__device__ __forceinline__ float sigmoid_f(float x) { return __builtin_amdgcn_rcpf(1.0f + __expf(-x)); }
__device__ __forceinline__ float softplus_f(float x) { return fmaxf(x, 0.0f) + log1pf(__expf(-fabsf(x))); }

constexpr int BM = 256, BK = 64, HALF = 128, HTB = HALF * BK * 2, NXCD = 8, WGM = 8;
__device__ __forceinline__ int lds_byte(int r, int c) { const int st = (r >> 4) * 2 + (c >> 5), rr = r & 15, cc = c & 31, ob = rr * 64 + cc * 2; return st * 1024 + (ob ^ (((ob >> 9) & 1) << 5)); }
__device__ __forceinline__ void stage_rc(int b, int& R, int& C) { const int st = b / 1024, sb = b % 1024, swz = sb ^ (((sb >> 9) & 1) << 5); R = (st >> 1) * 16 + swz / 64; C = (st & 1) * 32 + (swz % 64) / 2; }
__device__ __forceinline__ int perm32(int rho) { const int n = rho >> 4, i = rho & 15; return 8 * (i >> 2) + 4 * n + (i & 3); }

struct Unit { int pm, pn, kt0, nt, part, ok; };
struct Gemm { const bf16_t* A; const bf16_t* Bt; int lda, ldb, K, a_pn_off, tm; };
struct StaticOrder {
    int nM, nN, nwg, G, c, ntk;
    __device__ __forceinline__ void init(int M, int N, int G_, int c_, int K) { nM = M / BM; nN = N / BM; nwg = nM * nN; G = G_; c = c_; ntk = K / BK; }
    __device__ __forceinline__ Unit unit_of(int L) const {
        int wgid = L; { const int q = nwg / NXCD, r = nwg % NXCD, xcd = wgid % NXCD, off = wgid / NXCD; wgid = (xcd < r ? xcd * (q + 1) : r * (q + 1) + (xcd - r) * q) + off; }
        const int nig = WGM * nN, gid = wgid / nig, fm = gid * WGM, gsz = (nM - fm) < WGM ? (nM - fm) : WGM;
        Unit u; u.pm = fm + ((wgid % nig) % gsz); u.pn = (wgid % nig) / gsz; u.kt0 = 0; u.nt = ntk; u.part = -1; u.ok = 1; return u;
    }
    __device__ __forceinline__ Unit next(int i) const { const int L = i * G + c; Unit u = unit_of(L < nwg ? L : 0); u.ok = L < nwg; return u; }
};
struct SplitOrder {
    StaticOrder m; int nsub, nts;
    __device__ __forceinline__ void init(int N, int G_, int c_, int K, int ksplit) { m.init(MP, N, G_, c_, K); nsub = m.nN * ksplit; nts = m.ntk / ksplit; }
    __device__ __forceinline__ Unit next(int i) const {
        const int L = i * m.G + m.c;
        Unit u = m.unit_of(L < m.nwg ? L : 0);
        const int s = L - m.nwg;
        if (s >= 0) { u.pm = MP / BM; u.pn = s % m.nN; u.part = s / m.nN; u.kt0 = u.part * nts; u.nt = nts; u.ok = s < nsub; }
        return u;
    }
};

struct EpiF32 {
    static constexpr bool PERM = false;
    float* C; int ldc; float* P;
    __device__ __forceinline__ void operator()(const f32x4 (&acc)[2][2][4][2], const Unit u, int wr, int wc, int fr, int fq) const {
        const int col0 = u.pn * BM + wc * 32 + 4 * fq;
        if (u.part < 0) {
            const int row0 = u.pm * BM + wr * 64 + fr;
#pragma unroll
            for (int ai = 0; ai < 2; ++ai)
#pragma unroll
                for (int m = 0; m < 4; ++m) { float* rowp = C + (size_t)(row0 + ai * HALF + m * 16) * ldc + col0;
#pragma unroll
                    for (int bj = 0; bj < 2; ++bj)
#pragma unroll
                        for (int n = 0; n < 2; ++n) *(f32x4*)(rowp + bj * HALF + n * 16) = acc[ai][bj][m][n]; }
        } else {
#pragma unroll
            for (int m = 0; m < 4; ++m) { float* rowp = P + ((size_t)u.part * 128 + wr * 64 + fr + m * 16) * ldc + col0;
#pragma unroll
                for (int bj = 0; bj < 2; ++bj)
#pragma unroll
                    for (int n = 0; n < 2; ++n) *(f32x4*)(rowp + bj * HALF + n * 16) = acc[0][bj][m][n]; }
        }
    }
};
template <int ACT> struct EpiBf16 {
    static constexpr bool PERM = true;
    bf16_t* O; int ldc; int coloff;
    __device__ __forceinline__ void operator()(const f32x4 (&acc)[2][2][4][2], const Unit u, int wr, int wc, int fr, int fq) const {
        const int row0 = u.pm * BM + wr * 64 + fr, col0 = coloff + u.pn * BM + wc * 32 + 8 * fq;
#pragma unroll
        for (int ai = 0; ai < 2; ++ai)
#pragma unroll
            for (int m = 0; m < 4; ++m) { bf16_t* rowp = O + (size_t)(row0 + ai * HALF + m * 16) * ldc + col0;
#pragma unroll
                for (int bj = 0; bj < 2; ++bj) { f32x4 v0 = acc[ai][bj][m][0], v1 = acc[ai][bj][m][1];
                    if (ACT == 1) {
#pragma unroll
                        for (int j = 0; j < 4; ++j) { const float a = fmaxf(v0[j], 0.f), b = fmaxf(v1[j], 0.f); v0[j] = a * a; v1[j] = b * b; } }
                    u32x4 w; w.x = cvt_pk_bf16(v0[0], v0[1]); w.y = cvt_pk_bf16(v0[2], v0[3]); w.z = cvt_pk_bf16(v1[0], v1[1]); w.w = cvt_pk_bf16(v1[2], v1[3]);
                    *(u32x4*)(rowp + bj * HALF) = w; } }
    }
};
template <int ACT, int TM = 0> struct EpiBf16P {
    static constexpr bool PERM = true;
    bf16_t* O; int ldc; float* P;
    __device__ __forceinline__ void operator()(const f32x4 (&acc)[2][2][4][2], const Unit u, int wr, int wc, int fr, int fq) const {
        const int col0 = u.pn * BM + wc * 32 + 8 * fq;
        if (u.part < 0) {
            const int row0 = u.pm * BM + wr * 64 + fr;
#pragma unroll
            for (int ai = 0; ai < 2; ++ai)
#pragma unroll
                for (int m = 0; m < 4; ++m) { bf16_t* rowp = TM ? O + (size_t)u.pm * ((size_t)ldc * BM) + (size_t)(u.pn * 4 + (wc >> 1)) * (BM * BK) + (size_t)(wr * 64 + fr + ai * HALF + m * 16) * BK + (wc & 1) * 32 + 8 * fq
                                                                    : O + (size_t)(row0 + ai * HALF + m * 16) * ldc + col0;
#pragma unroll
                    for (int bj = 0; bj < 2; ++bj) { f32x4 v0 = acc[ai][bj][m][0], v1 = acc[ai][bj][m][1];
                        if (ACT == 1) {
#pragma unroll
                            for (int j = 0; j < 4; ++j) { const float p = fmaxf(v0[j], 0.f), q = fmaxf(v1[j], 0.f); v0[j] = p * p; v1[j] = q * q; } }
                        u32x4 w; w.x = cvt_pk_bf16(v0[0], v0[1]); w.y = cvt_pk_bf16(v0[2], v0[3]); w.z = cvt_pk_bf16(v1[0], v1[1]); w.w = cvt_pk_bf16(v1[2], v1[3]);
                        *(u32x4*)(rowp + (TM ? bj * 2 * (BM * BK) : bj * HALF)) = w; } }
        } else {
#pragma unroll
            for (int m = 0; m < 4; ++m) { float* rowp = P + ((size_t)u.part * 128 + wr * 64 + fr + m * 16) * ldc + col0;
#pragma unroll
                for (int bj = 0; bj < 2; ++bj) { *(f32x4*)(rowp + bj * HALF) = acc[0][bj][m][0]; *(f32x4*)(rowp + bj * HALF + 4) = acc[0][bj][m][1]; } }
        }
    }
};
struct EpiProj {
    static constexpr bool PERM = true;
    bf16_t* O; float* AB;
    __device__ __forceinline__ void operator()(const f32x4 (&acc)[2][2][4][2], const Unit u, int wr, int wc, int fr, int fq) const {
        const int row0 = u.pm * BM + wr * 64 + fr;
        if (u.pn < 20) {
            const int col0 = u.pn * BM + wc * 32 + 8 * fq;
#pragma unroll
            for (int ai = 0; ai < 2; ++ai)
#pragma unroll
                for (int m = 0; m < 4; ++m) { bf16_t* rowp = O + (size_t)(row0 + ai * HALF + m * 16) * NPROJ + col0;
#pragma unroll
                    for (int bj = 0; bj < 2; ++bj) { const f32x4 v0 = acc[ai][bj][m][0], v1 = acc[ai][bj][m][1];
                        u32x4 w; w.x = cvt_pk_bf16(v0[0], v0[1]); w.y = cvt_pk_bf16(v0[2], v0[3]); w.z = cvt_pk_bf16(v1[0], v1[1]); w.w = cvt_pk_bf16(v1[2], v1[3]);
                        *(u32x4*)(rowp + bj * HALF) = w; } }
        } else if (wc == 0 && fq < 2) {
#pragma unroll
            for (int ai = 0; ai < 2; ++ai)
#pragma unroll
                for (int m = 0; m < 4; ++m) { float* rowp = AB + (size_t)(row0 + ai * HALF + m * 16) * 16 + 8 * fq;
                    *(f32x4*)(rowp) = acc[ai][0][m][0]; *(f32x4*)(rowp + 4) = acc[ai][0][m][1]; }
        }
    }
};

template <class Epi, class Sched>
__device__ __forceinline__ void gemm_phase(LAS unsigned char* lds, const Gemm g, const Sched& S, const Epi& E) {
    const int tid = otid(), wid = __builtin_amdgcn_readfirstlane(tid >> 6), lane = tid & 63, wr = wid >> 2, wc = wid & 3, fr = lane & 15, fq = lane >> 4;
    unsigned voffA[2], voffB[2];
#pragma unroll
    for (int i = 0; i < 2; ++i) { int R, C; stage_rc(tid * 16 + i * 8192, R, C); const int Rb = Epi::PERM ? ((R & ~31) + perm32(R & 31)) : R;
        voffA[i] = (unsigned)(R * g.lda + C) * 2u; voffB[i] = (unsigned)(Rb * g.ldb + C) * 2u; }
    const size_t kstepA = g.tm ? (size_t)BM * BK * 2 : (size_t)(BK * 2), kstepB = kstepA;
    const size_t hstepA = (size_t)HALF * g.lda * 2, hstepB = (size_t)HALF * g.ldb * 2;
    const size_t tstepA = g.tm ? (size_t)(g.K / BK) * BM * BK * 2 : 2 * hstepA, tstepB = g.tm ? tstepA : 2 * hstepB;
    const unsigned ldsw = (unsigned)wid * 1024u;
    const int aoff = lds_byte(wr * 64 + fr, fq * 8), boff = lds_byte(wc * 32 + fr, fq * 8);
#define PG8_SA(b, h) (((b) * 2 + (h)) * HTB)
#define PG8_SB(b, h) ((4 + (b) * 2 + (h)) * HTB)
#define PG8_STAGE(bufoff, gbase, voff) do { _Pragma("unroll") for (int _i = 0; _i < 2; ++_i) \
        __builtin_amdgcn_global_load_lds((const unsigned*)((const char*)(gbase) + (voff)[_i]), (LAS unsigned*)(lds + (bufoff) + ldsw + _i * 8192), 16, 0, 0); } while (0)
#define PG8_LDA(dst, b, h) do { _Pragma("unroll") for (int m = 0; m < 4; ++m) _Pragma("unroll") for (int k = 0; k < 2; ++k) dst[m][k] = *(const LAS bf16x8*)(lds + PG8_SA(b, h) + aoff + m * 2048 + k * 1024); } while (0)
#define PG8_LDB(dst, b, h) do { _Pragma("unroll") for (int n = 0; n < 2; ++n) _Pragma("unroll") for (int k = 0; k < 2; ++k) dst[n][k] = *(const LAS bf16x8*)(lds + PG8_SB(b, h) + boff + n * 2048 + k * 1024); } while (0)
#define PG8_MMA(ai, bj, At, Bt) do { __builtin_amdgcn_s_setprio(1); _Pragma("unroll") for (int m = 0; m < 4; ++m) _Pragma("unroll") for (int n = 0; n < 2; ++n) _Pragma("unroll") for (int k = 0; k < 2; ++k) \
        acc[ai][bj][m][n] = __builtin_amdgcn_mfma_f32_16x16x32_bf16(Bt[n][k], At[m][k], acc[ai][bj][m][n], 0, 0, 0); __builtin_amdgcn_s_setprio(0); } while (0)
#define PG8_WAIT_V(n) asm volatile("s_waitcnt vmcnt(" #n ")" ::: "memory")
#define PG8_WAIT_L(n) asm volatile("s_waitcnt lgkmcnt(" #n ")" ::: "memory")
#define PG8_BAR __builtin_amdgcn_s_barrier()
#define PG8_SCHED __builtin_amdgcn_sched_barrier(0)
    Unit cur = S.next(0); int ui = 0;
    if (!cur.ok) return;
    f32x4 acc[2][2][4][2];
#pragma unroll
    for (int a = 0; a < 2; ++a)
#pragma unroll
        for (int b = 0; b < 2; ++b)
#pragma unroll
            for (int m = 0; m < 4; ++m)
#pragma unroll
                for (int n = 0; n < 2; ++n) acc[a][b][m][n] = (f32x4){0.f, 0.f, 0.f, 0.f};
    bf16x8 At[4][2], B0[2][2], B1[2][2];
    const char* cA = (const char*)g.A + (size_t)cur.pm * tstepA + (size_t)cur.pn * g.a_pn_off * 2 + (size_t)cur.kt0 * kstepA; const char* cB = (const char*)g.Bt + (size_t)cur.pn * tstepB + (size_t)cur.kt0 * kstepB;
    PG8_STAGE(PG8_SB(0, 0), cB, voffB); PG8_STAGE(PG8_SA(0, 0), cA, voffA); PG8_STAGE(PG8_SB(0, 1), cB + hstepB, voffB); PG8_STAGE(PG8_SA(0, 1), cA + hstepA, voffA);
    if (wr == 1) PG8_BAR;
    PG8_WAIT_V(4); PG8_BAR;
    PG8_STAGE(PG8_SB(1, 0), cB + kstepB, voffB); PG8_STAGE(PG8_SA(1, 0), cA + kstepA, voffA); PG8_STAGE(PG8_SB(1, 1), cB + hstepB + kstepB, voffB);
    PG8_WAIT_V(6); PG8_BAR;
    for (;;) {
        const Unit nxt = S.next(ui + 1); const bool has_next = nxt.ok != 0;
        const char* nA = has_next ? (const char*)g.A + (size_t)nxt.pm * tstepA + (size_t)nxt.pn * g.a_pn_off * 2 + (size_t)nxt.kt0 * kstepA : cA; const char* nB = has_next ? (const char*)g.Bt + (size_t)nxt.pn * tstepB + (size_t)nxt.kt0 * kstepB : cB;
        const int nt = cur.nt;
        for (int t = 0; t < nt; t += 2) {
            const bool last = (t == nt - 2);
            const char* a1 = cA + (size_t)(t + 1) * kstepA;
            const char* a2 = last ? nA : cA + (size_t)(t + 2) * kstepA; const char* b2 = last ? nB : cB + (size_t)(t + 2) * kstepB;
            const char* a3 = a2 + kstepA; const char* b3 = b2 + kstepB;
            PG8_LDB(B0, 0, 0); PG8_SCHED; PG8_LDA(At, 0, 0); PG8_STAGE(PG8_SA(1, 1), a1 + hstepA, voffA);
            PG8_WAIT_L(8); PG8_BAR; PG8_WAIT_L(0); PG8_MMA(0, 0, At, B0); PG8_BAR; PG8_SCHED;
            PG8_LDB(B1, 0, 1); PG8_STAGE(PG8_SB(0, 0), b2, voffB);
            PG8_BAR; PG8_WAIT_L(0); PG8_MMA(0, 1, At, B1); PG8_BAR;
            PG8_LDA(At, 0, 1); PG8_STAGE(PG8_SA(0, 0), a2, voffA);
            PG8_BAR; PG8_WAIT_L(0); PG8_MMA(1, 0, At, B0); PG8_BAR; PG8_SCHED;
            PG8_STAGE(PG8_SB(0, 1), b2 + hstepB, voffB);
            PG8_WAIT_V(6); PG8_BAR; PG8_MMA(1, 1, At, B1); PG8_BAR;
            PG8_LDB(B0, 1, 0); PG8_SCHED; PG8_LDA(At, 1, 0); PG8_STAGE(PG8_SA(0, 1), a2 + hstepA, voffA);
            PG8_WAIT_L(8); PG8_BAR; PG8_WAIT_L(0); PG8_MMA(0, 0, At, B0); PG8_BAR; PG8_SCHED;
            PG8_LDB(B1, 1, 1); PG8_STAGE(PG8_SB(1, 0), b3, voffB);
            PG8_BAR; PG8_WAIT_L(0); PG8_MMA(0, 1, At, B1); PG8_BAR;
            PG8_LDA(At, 1, 1); PG8_STAGE(PG8_SA(1, 0), a3, voffA);
            PG8_BAR; PG8_WAIT_L(0); PG8_MMA(1, 0, At, B0); PG8_BAR; PG8_SCHED;
            PG8_STAGE(PG8_SB(1, 1), b3 + hstepB, voffB);
            PG8_WAIT_V(6); PG8_BAR; PG8_MMA(1, 1, At, B1); PG8_BAR;
        }
        E(acc, cur, wr, wc, fr, fq);
        if (!has_next) break;
#pragma unroll
        for (int a = 0; a < 2; ++a)
#pragma unroll
            for (int b = 0; b < 2; ++b)
#pragma unroll
                for (int m = 0; m < 4; ++m)
#pragma unroll
                    for (int n = 0; n < 2; ++n) acc[a][b][m][n] = (f32x4){0.f, 0.f, 0.f, 0.f};
        cur = nxt; cA = nA; cB = nB; ++ui;
    }
    PG8_WAIT_V(0);
    if (wr == 0) PG8_BAR;
    PG8_BAR;
#undef PG8_SA
#undef PG8_SB
#undef PG8_STAGE
#undef PG8_LDA
#undef PG8_LDB
#undef PG8_MMA
#undef PG8_WAIT_V
#undef PG8_WAIT_L
#undef PG8_BAR
#undef PG8_SCHED
}

struct TDesc { const float* src; const float* scale; bf16_t* dst; int ld_src, k0, sc0, nv, ld_dst, n0, dk0; };
constexpr int TL_WIN = 0, TL_WOUT = 32 * 21, TL_WUP = TL_WOUT + 32 * 8, TL_WDN = TL_WUP + 32 * 32, TL_WPOOL = TL_WDN + 128 * 8, TL_END = TL_WPOOL + 16;
__device__ __forceinline__ TDesc tile_desc(const Args& a, int t) {
    unsigned char* ws = a.ws; TDesc d; d.scale = nullptr; d.nv = 256; d.dk0 = -1;
    if (t < TL_WOUT) { const int kt = t / 21, nt = t % 21, n0 = nt * 256;
        int sc0; if (n0 < 4096) sc0 = n0; else if (n0 < 5120) sc0 = n0 + 16; else { sc0 = 4096; d.nv = 16; }
        d.src = a.in[6]; d.ld_src = NIN; d.k0 = kt * 64; d.sc0 = sc0; d.dst = (bf16_t*)(ws + WS_WIN); d.ld_dst = DM; d.n0 = n0;
    } else if (t < TL_WUP) { const int u = t - TL_WOUT, kt = u / 8, nt = u % 8;
        d.src = a.in[13]; d.ld_src = DM; d.k0 = kt * 64; d.sc0 = nt * 256; d.dst = (bf16_t*)(ws + WS_WOUT); d.ld_dst = DM; d.n0 = nt * 256;
    } else if (t < TL_WDN) { const int u = t - TL_WUP, kt = u / 32, nt = u % 32;
        d.src = a.in[16]; d.ld_src = DFF; d.k0 = kt * 64; d.sc0 = nt * 256; d.dst = (bf16_t*)(ws + WS_WUP); d.ld_dst = DM; d.n0 = nt * 256;
    } else if (t < TL_WPOOL) { const int u = t - TL_WDN, kt = u / 8, nt = u % 8;
        d.src = a.in[17]; d.ld_src = DM; d.k0 = kt * 64; d.sc0 = nt * 256; d.dst = (bf16_t*)(ws + WS_WDN) + (size_t)nt * ((size_t)DFF * BM) + (size_t)kt * (BM * BK); d.ld_dst = BK; d.n0 = 0; d.dk0 = 0;
    } else { const int u = t - TL_WPOOL, g = u >> 2, kt = u & 3;
        d.src = a.in[11] + (size_t)g * 65536; d.ld_src = 256; d.k0 = kt * 64; d.sc0 = 0; d.dst = (bf16_t*)(ws + WS_WPOOL) + (size_t)g * 65536; d.ld_dst = 256; d.n0 = 0; d.scale = a.in[12] + g * 256;
    }
    if (d.dk0 < 0) d.dk0 = d.k0;
    return d;
}
__device__ __forceinline__ void convert_tiles(const Args& a, LAS unsigned char* lds, int t_lo, int t_hi, int first, int stride) {
    LAS float* tile = (LAS float*)lds;
    const int tid = otid();
    int t = t_lo + first;
    TDesc d = tile_desc(a, t < t_hi ? t : t_lo);
    f32x4 v[8];
#pragma unroll
    for (int i = 0; i < 8; ++i) { const int idx = tid + i * 512, r = idx >> 6, c4 = (idx & 63) * 4;
        v[i] = (f32x4){0.f, 0.f, 0.f, 0.f}; if (t < t_hi && c4 < d.nv) v[i] = __builtin_nontemporal_load((const f32x4*)(d.src + (size_t)(d.k0 + r) * d.ld_src + d.sc0 + c4)); }
    while (t < t_hi) {
#pragma unroll
        for (int i = 0; i < 8; ++i) { const int idx = tid + i * 512, r = idx >> 6, c4 = (idx & 63) * 4; *(LAS f32x4*)(tile + r * 260 + c4) = v[i]; }
        __syncthreads();
        const int tn = t + stride;
        const TDesc dn = tile_desc(a, tn < t_hi ? tn : t_lo);
#pragma unroll
        for (int i = 0; i < 8; ++i) { const int idx = tid + i * 512, r = idx >> 6, c4 = (idx & 63) * 4;
            v[i] = (f32x4){0.f, 0.f, 0.f, 0.f}; if (tn < t_hi && c4 < dn.nv) v[i] = __builtin_nontemporal_load((const f32x4*)(dn.src + (size_t)(dn.k0 + r) * dn.ld_src + dn.sc0 + c4)); }
#pragma unroll
        for (int j = 0; j < 4; ++j) {
            const int item = tid + j * 512, n = item >> 3, k8 = item & 7;
            const float sc = d.scale ? d.scale[n] : 1.0f;
            float x[8];
#pragma unroll
            for (int jj = 0; jj < 8; ++jj) x[jj] = tile[(k8 * 8 + jj) * 260 + n] * sc;
            u32x4 w; w.x = cvt_pk_bf16(x[0], x[1]); w.y = cvt_pk_bf16(x[2], x[3]); w.z = cvt_pk_bf16(x[4], x[5]); w.w = cvt_pk_bf16(x[6], x[7]);
            if (t >= TL_WUP && t < TL_WPOOL) __builtin_nontemporal_store(w, (u32x4*)(d.dst + (size_t)(d.n0 + n) * d.ld_dst + d.dk0 + k8 * 8));
            else *(u32x4*)(d.dst + (size_t)(d.n0 + n) * d.ld_dst + d.dk0 + k8 * 8) = w;
        }
        __syncthreads();
        t = tn; d = dn;
    }
}
__device__ __forceinline__ void convert_on_idle(const Args& a, LAS unsigned char* lds, int cblk, int lo, int t_lo, int t_hi) {
    const int G = (int)gridDim.x;
    if (G > lo) { if (cblk >= lo) convert_tiles(a, lds, t_lo, t_hi, cblk - lo, G - lo); }
    else convert_tiles(a, lds, t_lo, t_hi, cblk, G);
}

__device__ __forceinline__ void phase0(const Args& a, LAS unsigned char* lds) {
    unsigned char* ws = a.ws;
    convert_tiles(a, lds, TL_WIN, TL_WOUT, (int)blockIdx.x, (int)gridDim.x);
    convert_tiles(a, lds, TL_WPOOL, TL_END, (int)blockIdx.x, (int)gridDim.x);
    const int tid0 = otid(), lane = tid0 & 63, gw = blockIdx.x * 8 + (tid0 >> 6), nw = gridDim.x * 8;
    const float* nw_pre = a.in[5];
    bf16_t* H = (bf16_t*)(ws + WS_H);
    f32x4 vn[8];
    {   const int r0 = gw < MT ? gw : 0; const float* x0 = r0 < MP ? a.in[0] + (size_t)r0 * DM : a.in[1] + (size_t)(r0 - MP) * DM;
#pragma unroll
        for (int i = 0; i < 8; ++i) vn[i] = __builtin_nontemporal_load((const f32x4*)(x0 + (i * 64 + lane) * 4)); }
    for (int row = gw; row < MT; row += nw) {
        f32x4 v[8]; float ss = 0.f;
#pragma unroll
        for (int i = 0; i < 8; ++i) { v[i] = vn[i]; ss += v[i][0] * v[i][0] + v[i][1] * v[i][1] + v[i][2] * v[i][2] + v[i][3] * v[i][3]; }
        {   const int rn = row + nw < MT ? row + nw : row; const float* xn = rn < MP ? a.in[0] + (size_t)rn * DM : a.in[1] + (size_t)(rn - MP) * DM;
#pragma unroll
            for (int i = 0; i < 8; ++i) vn[i] = __builtin_nontemporal_load((const f32x4*)(xn + (i * 64 + lane) * 4)); }
        ss = wave_sum(ss);
        const float rs = rsqrtf(ss * (1.0f / DM) + EPS);
#pragma unroll
        for (int i = 0; i < 8; ++i) { const f32x4 w = *(const f32x4*)(nw_pre + (i * 64 + lane) * 4);
            u32x2 o; o.x = cvt_pk_bf16(v[i][0] * rs * w[0], v[i][1] * rs * w[1]); o.y = cvt_pk_bf16(v[i][2] * rs * w[2], v[i][3] * rs * w[3]);
            *(u32x2*)(H + (size_t)row * DM + (i * 64 + lane) * 4) = o; }
    }
}

constexpr int GRP_LDS = 70656, G_QB = 0, G_KB = 17408, G_VB = 34816, G_LM = 52224, G_GC = 69632, G_BETA = 69888, G_EGC = 70144, ROWB = 272;

__device__ __forceinline__ void gdn_chunk_prep(const Args& a, LAS unsigned char* lds) {
    const int tid = otid(), grp = tid >> 8, gt = tid & 255, gw = gt >> 6, lane = tid & 63, fr = lane & 15, fq = lane >> 4;
    LAS unsigned char* L = lds + grp * GRP_LDS;
    LAS float* gcs = (LAS float*)(L + G_GC); LAS float* betas = (LAS float*)(L + G_BETA); LAS float* egc = (LAS float*)(L + G_EGC); LAS float* Lm = (LAS float*)(L + G_LM);
    unsigned char* ws = a.ws;
    const bf16_t* PROJ = (const bf16_t*)(ws + WS_PROJ); const float* AB = (const float*)(ws + WS_AB);
    bf16_t* Wg = (bf16_t*)(ws + WS_W); bf16_t* QG = (bf16_t*)(ws + WS_QG); bf16_t* KDT = (bf16_t*)(ws + WS_KDT); bf16_t* INTRA = (bf16_t*)(ws + WS_INTRA); float* U = (float*)(ws + WS_U); float* GL = (float*)(ws + WS_GL);
    const float* convw = a.in[7];
    const int stride = gridDim.x * 2, niter = (NCH + stride - 1) / stride;
    for (int it = 0; it < niter; ++it) {
        const int cidx = it * stride + blockIdx.x * 2 + grp;
        const bool active = cidx < NCH;
        const int bh = cidx >> 5, n = cidx & 31, b = bh >> 3, h = bh & 7;
        const size_t row0 = (size_t)b * SEQ + n * 64;
        if (active) {
            const float av = AB[(row0 + lane) * 16 + h], bv = AB[(row0 + lane) * 16 + 8 + h];
            const int cq = h * 128 + 2 * lane;
            float cw[4][3][2];
#pragma unroll
            for (int j = 0; j < 4; ++j)
#pragma unroll
                for (int p = 0; p < 3; ++p) { const f32x2 w2 = *(const f32x2*)(convw + j * DQKV + p * 1024 + cq); cw[j][p][0] = w2[0]; cw[j][p][1] = w2[1]; }
            float xw[3][3][2];
            const int p0 = n * 64 + gw * 16;
#pragma unroll
            for (int j = 0; j < 3; ++j) { const int p = p0 - 3 + j;
#pragma unroll
                for (int q = 0; q < 3; ++q) { unsigned u = *(const unsigned*)(PROJ + ((size_t)b * SEQ + (p >= 0 ? p : 0)) * NPROJ + q * 1024 + cq); u = p >= 0 ? u : 0u; xw[j][q][0] = bf_lo(u); xw[j][q][1] = bf_hi(u); } }
            unsigned raw[16][3];
#pragma unroll
            for (int tt = 0; tt < 16; ++tt)
#pragma unroll
                for (int q = 0; q < 3; ++q) raw[tt][q] = __builtin_nontemporal_load((const unsigned*)(PROJ + (row0 + gw * 16 + tt) * NPROJ + q * 1024 + cq));
#pragma unroll
            for (int tg = 0; tg < 4; ++tg) {
                float y[4][3][2], red[8];
#pragma unroll
                for (int t4 = 0; t4 < 4; ++t4) {
#pragma unroll
                    for (int q = 0; q < 3; ++q) { const unsigned u = raw[tg * 4 + t4][q]; const float c0 = bf_lo(u), c1 = bf_hi(u);
                        float y0 = cw[0][q][0] * xw[0][q][0] + cw[1][q][0] * xw[1][q][0] + cw[2][q][0] * xw[2][q][0] + cw[3][q][0] * c0;
                        float y1 = cw[0][q][1] * xw[0][q][1] + cw[1][q][1] * xw[1][q][1] + cw[2][q][1] * xw[2][q][1] + cw[3][q][1] * c1;
                        xw[0][q][0] = xw[1][q][0]; xw[0][q][1] = xw[1][q][1]; xw[1][q][0] = xw[2][q][0]; xw[1][q][1] = xw[2][q][1]; xw[2][q][0] = c0; xw[2][q][1] = c1;
                        y[t4][q][0] = silu_f(y0); y[t4][q][1] = silu_f(y1); }
                    red[t4 * 2 + 0] = y[t4][0][0] * y[t4][0][0] + y[t4][0][1] * y[t4][0][1];
                    red[t4 * 2 + 1] = y[t4][1][0] * y[t4][1][0] + y[t4][1][1] * y[t4][1][1];
                }
#pragma unroll
                for (int o = 32; o >= 1; o >>= 1)
#pragma unroll
                    for (int k = 0; k < 8; ++k) red[k] += __shfl_xor(red[k], o);
#pragma unroll
                for (int t4 = 0; t4 < 4; ++t4) { const int i = gw * 16 + tg * 4 + t4;
                    const float rq = rsqrtf(red[t4 * 2] + EPS) * 0.08838834764831845f, rk = rsqrtf(red[t4 * 2 + 1] + EPS);
                    *(LAS unsigned*)(L + G_QB + i * ROWB + lane * 4) = cvt_pk_bf16(y[t4][0][0] * rq, y[t4][0][1] * rq);
                    *(LAS unsigned*)(L + G_KB + i * ROWB + lane * 4) = cvt_pk_bf16(y[t4][1][0] * rk, y[t4][1][1] * rk);
                    *(LAS unsigned*)(L + G_VB + i * ROWB + lane * 4) = cvt_pk_bf16(y[t4][2][0], y[t4][2][1]); }
            }
            if (gw == 0) {
                float gv = -__expf(a.in[8][h]) * softplus_f(av + a.in[9][h]);
#pragma unroll
                for (int o = 1; o < 64; o <<= 1) { const float t = __shfl_up(gv, o); if (lane >= o) gv += t; }
                gcs[lane] = gv; betas[lane] = sigmoid_f(bv); egc[lane] = __expf(gv);
            }
        }
        __syncthreads();
        if (active) {
            const int I = gw, i = 16 * I + fr;
            bf16x8 bK[4], bQ[4];
#pragma unroll
            for (int ks = 0; ks < 4; ++ks) { bK[ks] = *(const LAS bf16x8*)(L + G_KB + i * ROWB + ks * 64 + fq * 16); bQ[ks] = *(const LAS bf16x8*)(L + G_QB + i * ROWB + ks * 64 + fq * 16); }
            const float gci = gcs[i], bi = betas[i];
            for (int J = 0; J < 4; ++J) {
                u32x2 iv = (u32x2){0u, 0u};
                if (J <= I) {
                    f32x4 ck = (f32x4){0.f, 0.f, 0.f, 0.f}, cq2 = ck;
#pragma unroll
                    for (int ks = 0; ks < 4; ++ks) { const bf16x8 af = *(const LAS bf16x8*)(L + G_KB + (16 * J + fr) * ROWB + ks * 64 + fq * 16);
                        ck = __builtin_amdgcn_mfma_f32_16x16x32_bf16(af, bK[ks], ck, 0, 0, 0); cq2 = __builtin_amdgcn_mfma_f32_16x16x32_bf16(af, bQ[ks], cq2, 0, 0, 0); }
                    const f32x4 gj = *(const LAS f32x4*)(gcs + 16 * J + 4 * fq);
                    f32x4 lv; float ivf[4];
#pragma unroll
                    for (int r = 0; r < 4; ++r) { const int j = 16 * J + 4 * fq + r; const float dec = (j <= i) ? __expf(fminf(gci - gj[r], 0.f)) : 0.f;
                        lv[r] = (j < i) ? bi * ck[r] * dec : 0.f; ivf[r] = cq2[r] * dec; }
                    *(LAS f32x4*)(Lm + i * 68 + 16 * J + 4 * fq) = lv;
                    iv.x = cvt_pk_bf16(ivf[0], ivf[1]); iv.y = cvt_pk_bf16(ivf[2], ivf[3]);
                }
                *(u32x2*)(INTRA + (size_t)cidx * 4096 + ((I * 2 + (J >> 1)) * 64 + ((J & 1) * 2 + (fq >> 1)) * 16 + fr) * 8 + (fq & 1) * 4) = iv;
            }
            const float glast = gcs[63];
#pragma unroll
            for (int r = 0; r < 4; ++r) { const int item = gt + r * 256, ti = item >> 4, d8 = item & 15;
                const u32x4 qv = *(const LAS u32x4*)(L + G_QB + ti * ROWB + d8 * 16); const float e = egc[ti];
                u32x4 o; o.x = cvt_pk_bf16(bf_lo(qv.x) * e, bf_hi(qv.x) * e); o.y = cvt_pk_bf16(bf_lo(qv.y) * e, bf_hi(qv.y) * e); o.z = cvt_pk_bf16(bf_lo(qv.z) * e, bf_hi(qv.z) * e); o.w = cvt_pk_bf16(bf_lo(qv.w) * e, bf_hi(qv.w) * e);
                *(u32x4*)(QG + (size_t)cidx * 8192 + (((ti >> 4) * 4 + (d8 >> 2)) * 64 + (d8 & 3) * 16 + (ti & 15)) * 8) = o; }
#pragma unroll
            for (int r = 0; r < 4; ++r) { const int item = gt + r * 256, d = item & 127, i8 = item >> 7;
                float v[8];
#pragma unroll
                for (int j = 0; j < 8; ++j) { const int ti = i8 * 8 + j; v[j] = bf1(*(const LAS bf16_t*)(L + G_KB + ti * ROWB + d * 2)) * __expf(glast - gcs[ti]); }
                u32x4 o; o.x = cvt_pk_bf16(v[0], v[1]); o.y = cvt_pk_bf16(v[2], v[3]); o.z = cvt_pk_bf16(v[4], v[5]); o.w = cvt_pk_bf16(v[6], v[7]);
                *(u32x4*)(KDT + (size_t)cidx * 8192 + (((d >> 4) * 2 + (i8 >> 2)) * 64 + (i8 & 3) * 16 + (d & 15)) * 8) = o; }
            if (gt == 0) GL[cidx] = __expf(glast);
        }
        __syncthreads();
        if (active) {
            {
                const bool isw = gt >= 128; const int col = gt & 127;
                const LAS unsigned char* srcp = L + (isw ? G_KB : G_VB) + col * 2;
                float x[64];
#pragma unroll
                for (int i = 0; i < 64; ++i) {
                    f32x4 lq[16];
#pragma unroll
                    for (int q = 0; q < (i + 3) / 4; ++q) lq[q] = *(const LAS f32x4*)(Lm + i * 68 + q * 4);
                    float r0 = bf1(*(const LAS bf16_t*)(srcp + i * ROWB)) * betas[i];
                    if (isw) r0 *= egc[i];
                    float ac0 = r0, ac1 = 0.f, ac2 = 0.f, ac3 = 0.f;
#pragma unroll
                    for (int q = 0; q < (i + 3) / 4; ++q) {
                        if (q * 4 + 0 < i) ac0 -= lq[q][0] * x[q * 4 + 0];
                        if (q * 4 + 1 < i) ac1 -= lq[q][1] * x[q * 4 + 1];
                        if (q * 4 + 2 < i) ac2 -= lq[q][2] * x[q * 4 + 2];
                        if (q * 4 + 3 < i) ac3 -= lq[q][3] * x[q * 4 + 3];
                    }
                    const float acc = (ac0 + ac1) + (ac2 + ac3);
                    x[i] = acc;
                    if (isw) Wg[(size_t)cidx * 8192 + (((i >> 4) * 4 + (col >> 5)) * 64 + ((col >> 3) & 3) * 16 + (i & 15)) * 8 + (col & 7)] = (bf16_t)(cvt_pk_bf16(acc, 0.f) & 0xffffu);
                    else if ((i & 3) == 3) *(f32x4*)(U + (size_t)cidx * 8192 + (col >> 4) * 1024 + (i >> 4) * 256 + ((((i >> 2) & 3) * 16 + (col & 15)) * 4)) = (f32x4){x[i - 3], x[i - 2], x[i - 1], acc};
                }
            }
        }
        __syncthreads();
    }
}

template <int WIN>
__device__ __forceinline__ void pool_prompt_group(const bf16_t* PROJ, bf16_t* POOLED, int g, size_t gtid, size_t gsz) {
    for (size_t item = gtid; item < (size_t)MP * 32; item += gsz) {
        const int t = (int)(item >> 5), c8 = g * 32 + (int)(item & 31), p = t & (SEQ - 1);
        const int cnt = (p + 1) < WIN ? (p + 1) : WIN;
        u32x4 v[WIN];
#pragma unroll
        for (int j = 0; j < WIN; ++j) { const int jj = j < cnt ? j : 0; v[j] = *(const u32x4*)(PROJ + (size_t)(t - jj) * NPROJ + 4096 + c8 * 8); }
        float s[8] = {0.f, 0.f, 0.f, 0.f, 0.f, 0.f, 0.f, 0.f};
#pragma unroll
        for (int j = 0; j < WIN; ++j) { const float m = j < cnt ? 1.0f : 0.0f;
            s[0] += m * bf_lo(v[j].x); s[1] += m * bf_hi(v[j].x); s[2] += m * bf_lo(v[j].y); s[3] += m * bf_hi(v[j].y);
            s[4] += m * bf_lo(v[j].z); s[5] += m * bf_hi(v[j].z); s[6] += m * bf_lo(v[j].w); s[7] += m * bf_hi(v[j].w); }
        const float cur[8] = {bf_lo(v[0].x), bf_hi(v[0].x), bf_lo(v[0].y), bf_hi(v[0].y), bf_lo(v[0].z), bf_hi(v[0].z), bf_lo(v[0].w), bf_hi(v[0].w)};
        const float inv = 1.0f / (float)cnt;
        u32x4 o; o.x = cvt_pk_bf16(s[0] * inv - cur[0], s[1] * inv - cur[1]); o.y = cvt_pk_bf16(s[2] * inv - cur[2], s[3] * inv - cur[3]);
        o.z = cvt_pk_bf16(s[4] * inv - cur[4], s[5] * inv - cur[5]); o.w = cvt_pk_bf16(s[6] * inv - cur[6], s[7] * inv - cur[7]);
        *(u32x4*)(POOLED + (size_t)t * 1024 + c8 * 8) = o;
    }
}
template <int WIN>
__device__ __forceinline__ void pool_sample_group(const bf16_t* PROJ, const float* spool, bf16_t* POOLED, int g, size_t gtid, size_t gsz) {
    for (size_t item = gtid; item < (size_t)MS * 32; item += gsz) {
        const int b = (int)(item >> 5), c8 = g * 32 + (int)(item & 31);
        const u32x4 v = *(const u32x4*)(PROJ + (size_t)(MP + b) * NPROJ + 4096 + c8 * 8);
        f32x4 r0[WIN - 1], r1[WIN - 1];
#pragma unroll
        for (int j = 1; j < WIN; ++j) { const float* r = spool + ((size_t)b * 15 + (15 - j)) * 1024 + c8 * 8; r0[j - 1] = *(const f32x4*)r; r1[j - 1] = *(const f32x4*)(r + 4); }
        const float cur[8] = {bf_lo(v.x), bf_hi(v.x), bf_lo(v.y), bf_hi(v.y), bf_lo(v.z), bf_hi(v.z), bf_lo(v.w), bf_hi(v.w)};
        float s[8];
#pragma unroll
        for (int k = 0; k < 8; ++k) s[k] = cur[k];
#pragma unroll
        for (int j = 0; j < WIN - 1; ++j) { s[0] += r0[j][0]; s[1] += r0[j][1]; s[2] += r0[j][2]; s[3] += r0[j][3]; s[4] += r1[j][0]; s[5] += r1[j][1]; s[6] += r1[j][2]; s[7] += r1[j][3]; }
        const float inv = 1.0f / (float)WIN;
        u32x4 o; o.x = cvt_pk_bf16(s[0] * inv - cur[0], s[1] * inv - cur[1]); o.y = cvt_pk_bf16(s[2] * inv - cur[2], s[3] * inv - cur[3]);
        o.z = cvt_pk_bf16(s[4] * inv - cur[4], s[5] * inv - cur[5]); o.w = cvt_pk_bf16(s[6] * inv - cur[6], s[7] * inv - cur[7]);
        *(u32x4*)(POOLED + (size_t)(MP + b) * 1024 + c8 * 8) = o;
    }
}
__device__ __forceinline__ f32x4 bf4_to_f32(u32x2 u) { return (f32x4){bf_lo(u.x), bf_hi(u.x), bf_lo(u.y), bf_hi(u.y)}; }
__device__ __forceinline__ void pool_and_copies(const Args& a) {
    unsigned char* ws = a.ws;
    const bf16_t* PROJ = (const bf16_t*)(ws + WS_PROJ); bf16_t* POOLED = (bf16_t*)(ws + WS_POOLED);
    const size_t gtid = (size_t)blockIdx.x * 512 + otid(), gsz = (size_t)gridDim.x * 512;
    const float* spool = a.in[4]; const float* sconv = a.in[3];
    pool_prompt_group<2>(PROJ, POOLED, 0, gtid, gsz); pool_prompt_group<4>(PROJ, POOLED, 1, gtid, gsz);
    pool_prompt_group<8>(PROJ, POOLED, 2, gtid, gsz); pool_prompt_group<16>(PROJ, POOLED, 3, gtid, gsz);
    pool_sample_group<2>(PROJ, spool, POOLED, 0, gtid, gsz); pool_sample_group<4>(PROJ, spool, POOLED, 1, gtid, gsz);
    pool_sample_group<8>(PROJ, spool, POOLED, 2, gtid, gsz); pool_sample_group<16>(PROJ, spool, POOLED, 3, gtid, gsz);
    float* out = a.out;
    for (size_t e = gtid; e < (size_t)NBATCH * 15 * 256; e += gsz) { const int c4 = (int)(e & 255) * 4, r = (int)((e >> 8) % 15), b = (int)(e / (15 * 256));
        __builtin_nontemporal_store(bf4_to_f32(*(const u32x2*)(PROJ + ((size_t)b * SEQ + SEQ - 15 + r) * NPROJ + 4096 + c4)), (f32x4*)(out + OUT_POOL_P + e * 4)); }
    for (size_t e = gtid; e < (size_t)NBATCH * 3 * 768; e += gsz) { const int c4 = (int)(e % 768) * 4, r = (int)((e / 768) % 3), b = (int)(e / (3 * 768));
        __builtin_nontemporal_store(bf4_to_f32(*(const u32x2*)(PROJ + ((size_t)b * SEQ + SEQ - 3 + r) * NPROJ + c4)), (f32x4*)(out + OUT_CONV_P + e * 4)); }
    for (size_t e = gtid; e < (size_t)MS * 15 * 256; e += gsz) { const int c4 = (int)(e & 255) * 4, r = (int)((e >> 8) % 15), b = (int)(e / (15 * 256));
        __builtin_nontemporal_store((r < 14) ? __builtin_nontemporal_load((const f32x4*)(spool + ((size_t)b * 15 + r + 1) * 1024 + c4)) : bf4_to_f32(*(const u32x2*)(PROJ + (size_t)(MP + b) * NPROJ + 4096 + c4)), (f32x4*)(out + OUT_POOL_S + e * 4)); }
    for (size_t e = gtid; e < (size_t)MS * 3 * 768; e += gsz) { const int c4 = (int)(e % 768) * 4, r = (int)((e / 768) % 3), b = (int)(e / (3 * 768));
        __builtin_nontemporal_store((r < 2) ? __builtin_nontemporal_load((const f32x4*)(sconv + ((size_t)b * 3 + r + 1) * DQKV + c4)) : bf4_to_f32(*(const u32x2*)(PROJ + (size_t)(MP + b) * NPROJ + c4)), (f32x4*)(out + OUT_CONV_S + e * 4)); }
}

__device__ __forceinline__ void gdn_sample(const Args& a, LAS unsigned char* lds) {
    const int tid = otid(), lane = tid & 63, wid = tid >> 6;
    LAS float* qkv = (LAS float*)lds;
    LAS float* sc = qkv + 384;
    LAS float* part = qkv + 512;
    unsigned char* ws = a.ws;
    const bf16_t* PROJ = (const bf16_t*)(ws + WS_PROJ); const float* AB = (const float*)(ws + WS_AB); bf16_t* MIXIN = (bf16_t*)(ws + WS_H);
    const float* sconv = a.in[3]; const float* convw = a.in[7]; const float* S0 = a.in[2];
    float* Sout = a.out + OUT_GDN_S;
    f32x4 sraw[8];
    {   const int e4p = tid & 31, dgp = tid >> 5; const int u0 = blockIdx.x < MS * 8 ? blockIdx.x : 0;
        const float* Sp0 = S0 + ((size_t)u0 * 128 + dgp * 8) * 128 + e4p * 4;
#pragma unroll
        for (int i = 0; i < 8; ++i) sraw[i] = __builtin_nontemporal_load((const f32x4*)(Sp0 + (size_t)i * 128)); }
    float cwp[4], cxp[4]; u32x2 gvp; float avp, bvp;
#define SMP_LOAD(uu) do { const int _u = (uu) < MS * 8 ? (uu) : MS * 8 - 1; const int _b = _u >> 3, _h = _u & 7; const int _t = tid < 384 ? tid : 0; \
        const int _col = (_t >> 7) * 1024 + _h * 128 + (_t & 127); \
        _Pragma("unroll") for (int j = 0; j < 4; ++j) cwp[j] = convw[j * DQKV + _col]; \
        _Pragma("unroll") for (int j = 0; j < 3; ++j) cxp[j] = sconv[((size_t)_b * 3 + j) * DQKV + _col]; \
        cxp[3] = bf1(PROJ[(size_t)(MP + _b) * NPROJ + _col]); \
        gvp = *(const u32x2*)(PROJ + (size_t)(MP + _b) * NPROJ + 3072 + _h * 128 + (tid & 31) * 4); \
        avp = AB[(size_t)(MP + _b) * 16 + _h]; bvp = AB[(size_t)(MP + _b) * 16 + 8 + _h]; } while (0)
    SMP_LOAD((int)blockIdx.x);
    for (int unit = blockIdx.x; unit < MS * 8; unit += gridDim.x) {
        const int b = unit >> 3, h = unit & 7;
        const float ycv = cwp[0] * cxp[0] + cwp[1] * cxp[1] + cwp[2] * cxp[2] + cwp[3] * cxp[3];
        const u32x2 gv = gvp; const float av = avp, bv = bvp;
        SMP_LOAD(unit + (int)gridDim.x);
        if (tid < 384) qkv[tid] = silu_f(ycv);
        __syncthreads();
        if (wid < 2) { const float v0 = qkv[wid * 128 + lane], v1 = qkv[wid * 128 + 64 + lane]; const float ss = wave_sum(v0 * v0 + v1 * v1);
            const float rs = rsqrtf(ss + EPS) * (wid == 0 ? 0.08838834764831845f : 1.0f);
            qkv[wid * 128 + lane] = v0 * rs; qkv[wid * 128 + 64 + lane] = v1 * rs; }
        if (tid == 128) { sc[0] = __expf(-__expf(a.in[8][h]) * softplus_f(av + a.in[9][h])); sc[1] = sigmoid_f(bv); }
        __syncthreads();
        if (wid == 2) { const float d = wave_sum(qkv[lane] * qkv[128 + lane] + qkv[64 + lane] * qkv[192 + lane]); if (lane == 0) sc[2] = d; }
        const int e4 = tid & 31, dg = tid >> 5;
        const float eg = sc[0];
        f32x4 s[8]; f32x4 ks = (f32x4){0.f, 0.f, 0.f, 0.f}, qs = ks;
#pragma unroll
        for (int i = 0; i < 8; ++i) { s[i] = sraw[i] * eg; const float kd = qkv[128 + dg * 8 + i], qd = qkv[dg * 8 + i]; ks += s[i] * kd; qs += s[i] * qd; }
        {   const int nu = unit + (int)gridDim.x < MS * 8 ? unit + (int)gridDim.x : unit;
            const float* Spn = S0 + ((size_t)nu * 128 + dg * 8) * 128 + e4 * 4;
#pragma unroll
            for (int i = 0; i < 8; ++i) sraw[i] = __builtin_nontemporal_load((const f32x4*)(Spn + (size_t)i * 128)); }
        *(LAS f32x4*)(part + dg * 128 + e4 * 4) = ks; *(LAS f32x4*)(part + 2048 + dg * 128 + e4 * 4) = qs;
        __syncthreads();
        f32x4 kst = (f32x4){0.f, 0.f, 0.f, 0.f}, qst = kst;
#pragma unroll
        for (int g = 0; g < 16; ++g) { kst += *(const LAS f32x4*)(part + g * 128 + e4 * 4); qst += *(const LAS f32x4*)(part + 2048 + g * 128 + e4 * 4); }
        const f32x4 vv = *(const LAS f32x4*)(qkv + 256 + e4 * 4);
        const f32x4 delta = (vv - kst) * sc[1];
        float* So = Sout + ((size_t)unit * 128 + dg * 8) * 128 + e4 * 4;
#pragma unroll
        for (int i = 0; i < 8; ++i) __builtin_nontemporal_store(s[i] + delta * qkv[128 + dg * 8 + i], (f32x4*)(So + (size_t)i * 128));
        if (tid < 32) {
            const f32x4 o = qst + delta * sc[2];
            float ss = o[0] * o[0] + o[1] * o[1] + o[2] * o[2] + o[3] * o[3];
#pragma unroll
            for (int off = 16; off >= 1; off >>= 1) ss += __shfl_xor(ss, off);
            const float rs = rsqrtf(ss * (1.0f / 128.0f) + EPS);
            const f32x4 wn = *(const f32x4*)(a.in[10] + e4 * 4);
            u32x2 ov; ov.x = cvt_pk_bf16(o[0] * rs * wn[0] * silu_f(bf_lo(gv.x)), o[1] * rs * wn[1] * silu_f(bf_hi(gv.x)));
            ov.y = cvt_pk_bf16(o[2] * rs * wn[2] * silu_f(bf_lo(gv.y)), o[3] * rs * wn[3] * silu_f(bf_hi(gv.y)));
            *(u32x2*)(MIXIN + (size_t)(MP + b) * DM + h * 128 + e4 * 4) = ov;
        }
        __syncthreads();
    }
#undef SMP_LOAD
}

__device__ __forceinline__ void gdn_scan(const Args& a, LAS unsigned char* lds, int cblk) {
    const int tid = otid(), w = __builtin_amdgcn_readfirstlane(tid >> 6), lane = tid & 63, fr = lane & 15, fq = lane >> 4;
    const bool isV = w < 4; const int mt = w & 3;
    LAS unsigned char* St = lds; LAS unsigned char* Vt = lds + 4352;
    unsigned char* ws = a.ws;
    const float* GL = (const float*)(ws + WS_GL);
    float* O = a.out + OUT_Y;
    for (int blk = cblk; blk < 256; blk += gridDim.x) {
        const int bh = (blk & 7) * 4 + (blk >> 6), es = (blk >> 3) & 7, unit = bh * 8 + es;
        for (int i = tid; i < 4352 / 4; i += 512) ((LAS unsigned*)St)[i] = 0u;
        f32x4 Sacc = (f32x4){0.f, 0.f, 0.f, 0.f};
        const unsigned char* pA = ws + (isV ? WS_W : WS_QG) + ((size_t)bh * 32 * 8192 + (mt * 4 * 64 + lane) * 8) * 2;
        const unsigned char* pX = isV ? ws + WS_U + ((size_t)bh * 32 * 8192 + es * 1024 + mt * 256 + lane * 4) * 4
                                      : ws + WS_INTRA + ((size_t)bh * 32 * 4096 + (mt * 2 * 64 + lane) * 8) * 2;
        const size_t sX = isV ? 32768 : 8192; const int dX = isV ? 0 : 1024;
        const unsigned char* pK = ws + WS_KDT + ((size_t)bh * 32 * 8192 + (w * 2 * 64 + lane) * 8) * 2;
        bf16x8 af[4][4], xf[4][2], kf[4][2]; float gl[4];
#define SCAN_LOAD(s, nn) do { const int cn = (nn) < 32 ? (nn) : 31; \
            _Pragma("unroll") for (int ks = 0; ks < 4; ++ks) af[s][ks] = *(const bf16x8*)(pA + (size_t)cn * 16384 + ks * 1024); \
            xf[s][0] = *(const bf16x8*)(pX + (size_t)cn * sX); xf[s][1] = *(const bf16x8*)(pX + (size_t)cn * sX + dX); \
            _Pragma("unroll") for (int ks = 0; ks < 2; ++ks) kf[s][ks] = *(const bf16x8*)(pK + (size_t)cn * 16384 + ks * 1024); \
            gl[s] = GL[bh * 32 + cn]; } while (0)
        SCAN_LOAD(0, 0); SCAN_LOAD(1, 1); SCAN_LOAD(2, 2);
        __syncthreads();
        for (int g = 0; g < 8; ++g) {
#pragma unroll
            for (int j = 0; j < 4; ++j) {
                const int n = g * 4 + j;
                SCAN_LOAD((j + 3) % 4, n + 3);
                f32x4 acc0 = (f32x4){0.f, 0.f, 0.f, 0.f};
#pragma unroll
                for (int ks = 0; ks < 4; ++ks) { const bf16x8 sf = *(const LAS bf16x8*)(St + fr * 272 + ks * 64 + fq * 16);
                    acc0 = __builtin_amdgcn_mfma_f32_16x16x32_bf16(af[j][ks], sf, acc0, 0, 0, 0); }
                if (isV) {
                    const f32x4 vn = __builtin_bit_cast(f32x4, xf[j][0]) - acc0;
                    u32x2 pk; pk.x = cvt_pk_bf16(vn[0], vn[1]); pk.y = cvt_pk_bf16(vn[2], vn[3]);
                    *(LAS u32x2*)(Vt + fr * 144 + (mt * 16 + fq * 4) * 2) = pk;
                }
                __syncthreads();
                bf16x8 vf[2];
#pragma unroll
                for (int ks = 0; ks < 2; ++ks) vf[ks] = *(const LAS bf16x8*)(Vt + fr * 144 + ks * 64 + fq * 16);
                if (!isV) {
#pragma unroll
                    for (int ks = 0; ks < 2; ++ks) acc0 = __builtin_amdgcn_mfma_f32_16x16x32_bf16(xf[j][ks], vf[ks], acc0, 0, 0, 0);
#pragma unroll
                    for (int r = 0; r < 4; ++r) O[((size_t)unit * SEQ + n * 64 + mt * 16 + fq * 4 + r) * 16 + fr] = acc0[r];
                }
                Sacc *= gl[j];
#pragma unroll
                for (int ks = 0; ks < 2; ++ks) Sacc = __builtin_amdgcn_mfma_f32_16x16x32_bf16(kf[j][ks], vf[ks], Sacc, 0, 0, 0);
                { u32x2 pk; pk.x = cvt_pk_bf16(Sacc[0], Sacc[1]); pk.y = cvt_pk_bf16(Sacc[2], Sacc[3]); *(LAS u32x2*)(St + fr * 272 + (w * 16 + fq * 4) * 2) = pk; }
                __syncthreads();
            }
        }
#undef SCAN_LOAD
        float* Sp = (float*)(ws + WS_SS) + ((size_t)unit * 128 + w * 16 + fq * 4) * 16 + fr;
#pragma unroll
        for (int r = 0; r < 4; ++r) Sp[(size_t)r * 16] = Sacc[r];
        __syncthreads();
    }
}

__device__ __forceinline__ void gated_norm(const Args& a) {
    const int tidr = otid(), lane = tidr & 63, gw = blockIdx.x * 8 + (tidr >> 6), nw = gridDim.x * 8;
    const float* O = a.out + OUT_Y; const bf16_t* PROJ = (const bf16_t*)(a.ws + WS_PROJ); bf16_t* MIXIN = (bf16_t*)(a.ws + WS_H);
    const f32x2 wn = *(const f32x2*)(a.in[10] + 2 * lane);
    f32x2 on[4]; unsigned gn[4];
#define GN_LOAD(it0) do { const int _i0 = (it0) < MP * 8 ? (it0) : MP * 8 - 4; const int _t = _i0 >> 3, _h0 = _i0 & 7; \
        _Pragma("unroll") for (int k = 0; k < 4; ++k) { const int h = _h0 + k; \
            on[k] = __builtin_nontemporal_load((const f32x2*)(O + ((size_t)(((_t >> 11) * 8 + h) * 8 + (lane >> 3)) * SEQ + (_t & (SEQ - 1))) * 16 + ((2 * lane) & 15))); \
            gn[k] = __builtin_nontemporal_load((const unsigned*)(PROJ + (size_t)_t * NPROJ + 3072 + h * 128 + 2 * lane)); } } while (0)
    GN_LOAD(gw * 4);
    for (int item0 = gw * 4; item0 < MP * 8; item0 += nw * 4) {
        const int t = item0 >> 3, h0 = item0 & 7;
        f32x2 o[4]; unsigned gv[4];
#pragma unroll
        for (int k = 0; k < 4; ++k) { o[k] = on[k]; gv[k] = gn[k]; }
        GN_LOAD(item0 + nw * 4);
#pragma unroll
        for (int k = 0; k < 4; ++k) { const int h = h0 + k;
            const float ss = wave_sum(o[k][0] * o[k][0] + o[k][1] * o[k][1]);
            const float rs = rsqrtf(ss * (1.0f / 128.0f) + EPS);
            *(unsigned*)(MIXIN + (size_t)t * DM + h * 128 + 2 * lane) = cvt_pk_bf16(o[k][0] * rs * wn[0] * silu_f(bf_lo(gv[k])), o[k][1] * rs * wn[1] * silu_f(bf_hi(gv[k]))); }
    }
#undef GN_LOAD
}
__device__ __forceinline__ void copy_final_state(const Args& a) {
    const float* SS = (const float*)(a.ws + WS_SS); float* out = a.out + OUT_GDN_P;
    const size_t gtid = (size_t)blockIdx.x * 512 + otid(), gsz = (size_t)gridDim.x * 512;
    for (size_t e4 = gtid; e4 < (size_t)32 * 128 * 32; e4 += gsz) { const int ee = (int)(e4 & 31) * 4, d = (int)((e4 >> 5) & 127), bh = (int)(e4 >> 12);
        __builtin_nontemporal_store(__builtin_nontemporal_load((const f32x4*)(SS + ((size_t)(bh * 8 + (ee >> 4)) * 128 + d) * 16 + (ee & 15))), (f32x4*)(out + e4 * 4)); }
}

__device__ __forceinline__ void load_row_bf16_or_partials(f32x4 (&v)[8], const bf16_t* B, const float* P, int ks, int row, int lane) {
    if (row < MP) {
#pragma unroll
        for (int i = 0; i < 8; ++i) { const u32x2 u = *(const u32x2*)(B + (size_t)row * DM + (i * 64 + lane) * 4); v[i] = (f32x4){bf_lo(u.x), bf_hi(u.x), bf_lo(u.y), bf_hi(u.y)}; }
    } else {
#pragma unroll
        for (int i = 0; i < 8; ++i) v[i] = (f32x4){0.f, 0.f, 0.f, 0.f};
#pragma unroll 4
        for (int p = 0; p < ks; ++p) { const float* pp = P + ((size_t)p * 128 + (row - MP)) * DM + lane * 4;
#pragma unroll
            for (int i = 0; i < 8; ++i) v[i] += *(const f32x4*)(pp + i * 256); }
    }
}
__device__ __forceinline__ void row_phase_mid(const Args& a) {
    const int tidr = otid(), lane = tidr & 63, gw = blockIdx.x * 8 + (tidr >> 6), nw = gridDim.x * 8;
    const bf16_t* MIX = (const bf16_t*)(a.ws + WS_MIX); bf16_t* HM = (bf16_t*)(a.ws + WS_H); bf16_t* X1 = (bf16_t*)(a.ws + WS_X1);
    const float* w1 = a.in[14]; const float* w2 = a.in[15];
    u32x2 raw[8];
#pragma unroll
    for (int i = 0; i < 8; ++i) raw[i] = *(const u32x2*)(MIX + (size_t)(gw < MP ? gw : 0) * DM + (i * 64 + lane) * 4);
    for (int row = gw; row < MT; row += nw) {
        const float* x = row < MP ? a.in[0] + (size_t)row * DM : a.in[1] + (size_t)(row - MP) * DM;
        f32x4 v[8]; float ss = 0.f;
        if (row < MP) {
#pragma unroll
            for (int i = 0; i < 8; ++i) v[i] = (f32x4){bf_lo(raw[i].x), bf_hi(raw[i].x), bf_lo(raw[i].y), bf_hi(raw[i].y)};
        } else load_row_bf16_or_partials(v, MIX, (const float*)(a.ws + WS_PART5), KS5, row, lane);
        {   const int nr = (row + nw < MP) ? row + nw : MP - 1;
#pragma unroll
            for (int i = 0; i < 8; ++i) raw[i] = __builtin_nontemporal_load((const u32x2*)(MIX + (size_t)nr * DM + (i * 64 + lane) * 4)); }
#pragma unroll
        for (int i = 0; i < 8; ++i) ss += v[i][0] * v[i][0] + v[i][1] * v[i][1] + v[i][2] * v[i][2] + v[i][3] * v[i][3];
        ss = wave_sum(ss);
        const float rs = rsqrtf(ss * (1.0f / DM) + EPS);
        float ss2 = 0.f;
#pragma unroll
        for (int i = 0; i < 8; ++i) { const f32x4 xv = __builtin_nontemporal_load((const f32x4*)(x + (i * 64 + lane) * 4)), w = *(const f32x4*)(w1 + (i * 64 + lane) * 4);
            v[i] = xv + v[i] * rs * w; ss2 += v[i][0] * v[i][0] + v[i][1] * v[i][1] + v[i][2] * v[i][2] + v[i][3] * v[i][3];
            u32x2 o; o.x = cvt_pk_bf16(v[i][0], v[i][1]); o.y = cvt_pk_bf16(v[i][2], v[i][3]);
            __builtin_nontemporal_store(o, (u32x2*)(X1 + (size_t)row * DM + (i * 64 + lane) * 4)); }
        ss2 = wave_sum(ss2);
        const float rs2 = rsqrtf(ss2 * (1.0f / DM) + EPS);
#pragma unroll
        for (int i = 0; i < 8; ++i) { const f32x4 w = *(const f32x4*)(w2 + (i * 64 + lane) * 4);
            u32x2 o; o.x = cvt_pk_bf16(v[i][0] * rs2 * w[0], v[i][1] * rs2 * w[1]); o.y = cvt_pk_bf16(v[i][2] * rs2 * w[2], v[i][3] * rs2 * w[3]);
            *(u32x2*)(HM + (size_t)row * DM + (i * 64 + lane) * 4) = o; }
    }
}
__device__ __forceinline__ void row_phase_final(const Args& a) {
    const int tidr = otid(), lane = tidr & 63, gw = blockIdx.x * 8 + (tidr >> 6), nw = gridDim.x * 8;
    const bf16_t* FF = (const bf16_t*)(a.ws + WS_FF); const bf16_t* X1 = (const bf16_t*)(a.ws + WS_X1); float* Y = a.out + OUT_Y; const float* w1 = a.in[18];
    u32x2 raw[8];
#pragma unroll
    for (int i = 0; i < 8; ++i) raw[i] = *(const u32x2*)(FF + (size_t)(gw < MP ? gw : 0) * DM + (i * 64 + lane) * 4);
    for (int row = gw; row < MT; row += nw) {
        f32x4 v[8]; float ss = 0.f;
        if (row < MP) {
#pragma unroll
            for (int i = 0; i < 8; ++i) v[i] = (f32x4){bf_lo(raw[i].x), bf_hi(raw[i].x), bf_lo(raw[i].y), bf_hi(raw[i].y)};
        } else load_row_bf16_or_partials(v, FF, (const float*)(a.ws + WS_PART8), KS8, row, lane);
        {   const int nr = (row + nw < MP) ? row + nw : MP - 1;
#pragma unroll
            for (int i = 0; i < 8; ++i) raw[i] = __builtin_nontemporal_load((const u32x2*)(FF + (size_t)nr * DM + (i * 64 + lane) * 4)); }
#pragma unroll
        for (int i = 0; i < 8; ++i) ss += v[i][0] * v[i][0] + v[i][1] * v[i][1] + v[i][2] * v[i][2] + v[i][3] * v[i][3];
        ss = wave_sum(ss);
        const float rs = rsqrtf(ss * (1.0f / DM) + EPS);
#pragma unroll
        for (int i = 0; i < 8; ++i) { const u32x2 u = __builtin_nontemporal_load((const u32x2*)(X1 + (size_t)row * DM + (i * 64 + lane) * 4)); const f32x4 xv = (f32x4){bf_lo(u.x), bf_hi(u.x), bf_lo(u.y), bf_hi(u.y)}, w = *(const f32x4*)(w1 + (i * 64 + lane) * 4);
            __builtin_nontemporal_store(xv + v[i] * rs * w, (f32x4*)(Y + (size_t)row * DM + (i * 64 + lane) * 4)); }
    }
}

#define XB_TMO      128
#define XB_XCNT(j)  (256  + 64 * (j))
#define XB_XSUB(j)  (1280 + 64 * (j))
#define XB_XGEN(j)  (2304 + 64 * (j))
#define XB_TOP      3328
#define XB_TOPGEN   3392
#define XCD_BAR_WORDS 3456
#define XB_SPIN_CAP (1u << 18)
__device__ __forceinline__ unsigned xb_ld(unsigned* p)              { return __hip_atomic_load(p, __ATOMIC_RELAXED, __HIP_MEMORY_SCOPE_AGENT); }
__device__ __forceinline__ unsigned xb_add(unsigned* p, unsigned v) { return __hip_atomic_fetch_add(p, v, __ATOMIC_RELAXED, __HIP_MEMORY_SCOPE_AGENT); }
__device__ __forceinline__ unsigned xb_xcc_id() { return (unsigned)__builtin_amdgcn_s_getreg((3 << 11) | 20) & 0xFu; }
#define XB_SPIN(cond, bar) do { unsigned _sp = 0; while (cond) { __builtin_amdgcn_s_sleep(1); \
    if ((++_sp & 255u) == 0u) { if (xb_ld(&(bar)[XB_TMO])) break; if (_sp > XB_SPIN_CAP) { atomicAdd(&(bar)[XB_TMO], 1u); break; } } } } while (0)
struct XcdBarrier { unsigned* bar; unsigned x; volatile LAS unsigned* st; };
__device__ __forceinline__ XcdBarrier xcd_barrier_post(unsigned* bar, volatile LAS unsigned* st) {
    XcdBarrier b; b.bar = bar; b.x = xb_xcc_id(); b.st = st;
    if (threadIdx.x == 0) st[2] = xb_add(&bar[XB_XCNT(b.x)], 1u);
    return b;
}
__device__ __forceinline__ void xcd_barrier_complete(unsigned* bar, unsigned x, unsigned& nloc, unsigned& nx) {
    const unsigned G = gridDim.x * gridDim.y * gridDim.z;
    unsigned sum, cnt, mine, sp = 0u;
    for (;;) {
        sum = 0u; cnt = 0u; mine = 0u;
#pragma unroll
        for (unsigned j = 0; j < 16; ++j) { const unsigned c = xb_ld(&bar[XB_XCNT(j)]); sum += c; cnt += (c > 0u) ? 1u : 0u; mine = (j == x) ? c : mine; }
        if (sum == G) break;
        __builtin_amdgcn_s_sleep(1);
        if ((++sp & 255u) == 0u) { if (xb_ld(&bar[XB_TMO])) break; if (sp > XB_SPIN_CAP) { atomicAdd(&bar[XB_TMO], 1u); break; } }
    }
    nloc = mine > 0u ? mine : 1u; nx = cnt > 0u ? cnt : 1u;
}
__device__ __forceinline__ void xcd_barrier(const XcdBarrier& b) {
    asm volatile("s_waitcnt vmcnt(0)" ::: "memory");
    __syncthreads();
    if (threadIdx.x == 0) {
        unsigned* bar = b.bar;
        __builtin_amdgcn_s_waitcnt(0);
        unsigned nloc = b.st[0], nx = b.st[1];
        if (nloc == 0u) { xcd_barrier_complete(bar, b.x, nloc, nx); b.st[0] = nloc; b.st[1] = nx; }
        const unsigned old = xb_add(&bar[XB_XSUB(b.x)], 1u);
        const unsigned gen = old / nloc;
        if (old + 1u == (gen + 1u) * nloc) {
            __builtin_amdgcn_fence(__ATOMIC_RELEASE, "agent");
            asm volatile("s_waitcnt vmcnt(0)" ::: "memory");
            const unsigned og = xb_add(&bar[XB_TOP], 1u);
            const unsigned tg = og / nx;
            if (og + 1u == (tg + 1u) * nx) xb_add(&bar[XB_TOPGEN], 1u);
            else XB_SPIN(xb_ld(&bar[XB_TOPGEN]) == tg, bar);
            __builtin_amdgcn_fence(__ATOMIC_ACQUIRE, "agent");
            xb_add(&bar[XB_XGEN(b.x)], 1u);
            asm volatile("s_waitcnt vmcnt(0)" ::: "memory");
        } else {
            XB_SPIN(xb_ld(&bar[XB_XGEN(b.x)]) == gen, bar);
            __builtin_amdgcn_fence(__ATOMIC_ACQUIRE, "agent");
            asm volatile("s_waitcnt vmcnt(0)" ::: "memory");
        }
    }
    __syncthreads();
}

__device__ __forceinline__ void grid_sync(cg::grid_group& grid) {
    asm volatile("s_waitcnt vmcnt(0) lgkmcnt(0)" ::: "memory");
    grid.sync();
    __builtin_amdgcn_fence(__ATOMIC_ACQUIRE, "agent");
    asm volatile("s_waitcnt vmcnt(0)" ::: "memory");
}

#ifdef STOPK
__device__ __forceinline__ void probe_dump(const Args& a, int which) {
    const size_t gtid = (size_t)blockIdx.x * 512 + otid(), gsz = (size_t)gridDim.x * 512;
    const bf16_t* src = (const bf16_t*)(a.ws + ((which == 1 || which == 5) ? WS_PROJ : which == 2 ? WS_QG : WS_H));
    if (which == 5) {
        const float* ab = (const float*)(a.ws + WS_AB);
        for (size_t e = gtid; e < 37584896; e += gsz) a.out[e] = (e < 16777216) ? bf1(src[(size_t)MPAD * NPROJ - 1 - e * 2]) : (e < 16777216 + (size_t)MPAD * 16 ? ab[e - 16777216] : 0.f);
        return; }
    if (which == 2) { for (size_t e = gtid; e < 37584896; e += gsz) a.out[e] = (e < 8388608) ? ((const float*)(a.ws + WS_U))[e] : (e < 8388608 + 1024 ? ((const float*)(a.ws + WS_GL))[e - 8388608] : 0.f); return; }
    for (size_t e = gtid; e < 37584896; e += gsz) a.out[e] = (e < 16777216) ? bf1(src[e * 2]) : 0.f;
}
#endif
__global__ __launch_bounds__(512, 2) void fwd_megakernel(Args a) {
    extern __shared__ __attribute__((aligned(16))) unsigned char shm[];
    LAS unsigned char* lds = (LAS unsigned char*)shm;
    cg::grid_group grid = cg::this_grid();
    unsigned char* ws = a.ws;
    StaticOrder S;
    volatile LAS unsigned* bst = (volatile LAS unsigned*)(lds + LDS_BYTES - 16);
    if (threadIdx.x < 4) bst[threadIdx.x] = 0u;
    __syncthreads();
    const XcdBarrier xbar = xcd_barrier_post((unsigned*)(ws + WS_BAR), bst);

    if (a.ws == nullptr) grid_sync(grid);
    phase0(a, lds);
    xcd_barrier(xbar);
    const unsigned crk = bst[2];
    bool even = xbar.x < 8u;
#pragma unroll
    for (int j = 0; j < 8; ++j) even = even && (xb_ld((unsigned*)(ws + WS_BAR) + XB_XCNT(j)) * 8u == gridDim.x);
    const int cblk = __builtin_amdgcn_readfirstlane((even && crk * 8u < gridDim.x) ? (int)(crk * 8u + xbar.x) : (int)blockIdx.x);
    {
        Gemm g{(const bf16_t*)(ws + WS_H), (const bf16_t*)(ws + WS_WIN), DM, DM, DM, 0, 0};
        EpiProj E{(bf16_t*)(ws + WS_PROJ), (float*)(ws + WS_AB)};
        S.init(MPAD, NPADW, gridDim.x, cblk, DM);
        gemm_phase(lds, g, S, E);
        convert_on_idle(a, lds, cblk, S.nwg % (int)gridDim.x, TL_WUP, TL_WDN);
#if DOUBLE_PHASE == 18
        gemm_phase(lds, g, S, E);
#endif
    }
    xcd_barrier(xbar);
#if DOUBLE_PHASE == 99
    xcd_barrier(xbar);
#endif
#if defined(STOPK) && STOPK == 1
    probe_dump(a, 5); return;
#endif
    gdn_chunk_prep(a, lds);
    pool_and_copies(a);
    gdn_sample(a, lds);
#if DOUBLE_PHASE == 2
    gdn_chunk_prep(a, lds);
#endif

#if DOUBLE_PHASE == 21
    pool_and_copies(a);
    gdn_sample(a, lds);
#endif
    xcd_barrier(xbar);
#if DOUBLE_PHASE == 99
    xcd_barrier(xbar);
#endif
#if defined(STOPK) && STOPK == 2
    probe_dump(a, 2); return;
#endif
    gdn_scan(a, lds, cblk);
#if DOUBLE_PHASE == 3
    gdn_scan(a, lds, cblk);
#endif
    {
        Gemm g{(const bf16_t*)(ws + WS_POOLED), (const bf16_t*)(ws + WS_WPOOL), 1024, 256, 256, 256, 0};
        EpiBf16<0> E{(bf16_t*)(ws + WS_H), DM, 1024};
        S.init(MPAD, 1024, gridDim.x, cblk, 256);
        gemm_phase(lds, g, S, E);
        convert_on_idle(a, lds, cblk, S.nwg % (int)gridDim.x, TL_WOUT, TL_WUP);
    }
    xcd_barrier(xbar);
#if DOUBLE_PHASE == 99
    xcd_barrier(xbar);
#endif
#if defined(STOPK) && STOPK == 3
    { const size_t gtid = (size_t)blockIdx.x * 512 + otid(), gsz = (size_t)gridDim.x * 512;
      for (size_t e = gtid + PROBE3_KEEP; e < 37584896; e += gsz) a.out[e] = 0.f; return; }
#endif
    gated_norm(a);
    copy_final_state(a);
#if DOUBLE_PHASE == 4
    gated_norm(a);
#endif
    xcd_barrier(xbar);
#if DOUBLE_PHASE == 99
    xcd_barrier(xbar);
#endif
#if defined(STOPK) && STOPK == 4
    probe_dump(a, 4); return;
#endif
    {
        Gemm g{(const bf16_t*)(ws + WS_H), (const bf16_t*)(ws + WS_WOUT), DM, DM, DM, 0, 0};
        EpiBf16P<0> E{(bf16_t*)(ws + WS_MIX), DM, (float*)(ws + WS_PART5)};
        SplitOrder S2; S2.init(DM, gridDim.x, cblk, DM, KS5);
        gemm_phase(lds, g, S2, E);
        convert_on_idle(a, lds, cblk, (S2.m.nwg + S2.nsub) % (int)gridDim.x, TL_WDN, TL_WPOOL);
#if DOUBLE_PHASE == 5
        gemm_phase(lds, g, S, E);
#endif
    }
    xcd_barrier(xbar);
#if DOUBLE_PHASE == 99
    xcd_barrier(xbar);
#endif
    row_phase_mid(a);
#if DOUBLE_PHASE == 4
    row_phase_mid(a);
#endif
    xcd_barrier(xbar);
#if DOUBLE_PHASE == 99
    xcd_barrier(xbar);
#endif
    {
        Gemm g{(const bf16_t*)(ws + WS_H), (const bf16_t*)(ws + WS_WUP), DM, DM, DM, 0, 0};
        EpiBf16P<1, 1> E{(bf16_t*)(ws + WS_FF1), DFF, (float*)(ws + WS_PART7)};
        SplitOrder S2; S2.init(DFF, gridDim.x, cblk, DM, KS7);
        gemm_phase(lds, g, S2, E);
#if DOUBLE_PHASE == 7
        gemm_phase(lds, g, S, E);
#endif
    }
    xcd_barrier(xbar);
#if DOUBLE_PHASE == 99
    xcd_barrier(xbar);
#endif
    {
        const float* P7 = (const float*)(ws + WS_PART7); bf16_t* FF1 = (bf16_t*)(ws + WS_FF1);
        const size_t gtid = (size_t)blockIdx.x * 512 + otid(), gsz = (size_t)gridDim.x * 512;
        for (size_t item = gtid; item < (size_t)MS * (DFF / 8); item += gsz) {
            const int r = (int)(item >> 10), c8 = (int)(item & 1023);
            f32x4 s0 = (f32x4){0.f, 0.f, 0.f, 0.f}, s1 = s0;
#pragma unroll
            for (int p = 0; p < KS7; ++p) { const float* pp = P7 + ((size_t)p * 128 + r) * DFF + c8 * 8; s0 += __builtin_nontemporal_load((const f32x4*)pp); s1 += __builtin_nontemporal_load((const f32x4*)(pp + 4)); }
#pragma unroll
            for (int j = 0; j < 4; ++j) { const float p = fmaxf(s0[j], 0.f), q = fmaxf(s1[j], 0.f); s0[j] = p * p; s1[j] = q * q; }
            u32x4 w; w.x = cvt_pk_bf16(s0[0], s0[1]); w.y = cvt_pk_bf16(s0[2], s0[3]); w.z = cvt_pk_bf16(s1[0], s1[1]); w.w = cvt_pk_bf16(s1[2], s1[3]);
            *(u32x4*)(FF1 + (size_t)(MP / BM) * ((size_t)DFF * BM) + (size_t)(c8 >> 3) * (BM * BK) + (size_t)r * BK + (c8 & 7) * 8) = w;
        }
    }
    xcd_barrier(xbar);
    {
        Gemm g{(const bf16_t*)(ws + WS_FF1), (const bf16_t*)(ws + WS_WDN), BK, BK, DFF, 0, 1};
        EpiBf16P<0> E{(bf16_t*)(ws + WS_FF), DM, (float*)(ws + WS_PART8)};
        SplitOrder S2; S2.init(DM, gridDim.x, cblk, DFF, KS8);
        gemm_phase(lds, g, S2, E);
#if DOUBLE_PHASE == 18
        gemm_phase(lds, g, S2, E);
#endif
    }
    xcd_barrier(xbar);
#if DOUBLE_PHASE == 99
    xcd_barrier(xbar);
#endif
    row_phase_final(a);
}

extern "C" void kernel_launch(void* const* d_in, const int* in_sizes, int n_in, void* d_out, int out_size, void* d_ws, size_t ws_size, hipStream_t stream) {
    static int grid_blocks = 0;
    if (grid_blocks == 0) {
        if (n_in != 19 || ws_size < WS_END) { fprintf(stderr, "kernel_launch: need 19 inputs and >= %zu bytes of workspace (got %d, %zu)\n", (size_t)WS_END, n_in, ws_size); grid_blocks = -1; return; }
        int dev = 0, cus = 0, per_cu = 0;
        hipGetDevice(&dev);
        hipDeviceGetAttribute(&cus, hipDeviceAttributeMultiprocessorCount, dev);
        if (hipFuncSetAttribute((const void*)fwd_megakernel, hipFuncAttributeMaxDynamicSharedMemorySize, LDS_BYTES) != hipSuccess) { fprintf(stderr, "kernel_launch: hipFuncSetAttribute failed\n"); grid_blocks = -1; return; }
        hipOccupancyMaxActiveBlocksPerMultiprocessor(&per_cu, (const void*)fwd_megakernel, 512, LDS_BYTES);
        if (per_cu < 1) { fprintf(stderr, "kernel_launch: occupancy query says %d blocks per CU\n", per_cu); per_cu = 1; }
        (void)hipGetLastError();
        grid_blocks = cus;
    }
    if (grid_blocks < 0) return;
    Args a{};
    for (int i = 0; i < 19; ++i) a.in[i] = (const float*)d_in[i];
    a.out = (float*)d_out; a.ws = (unsigned char*)d_ws;
    (void)hipMemsetAsync((unsigned char*)d_ws + WS_BAR, 0, XCD_BAR_WORDS * 4, stream);
    void* args[] = {&a};
    hipError_t e = hipLaunchCooperativeKernel((const void*)fwd_megakernel, dim3(grid_blocks), dim3(512), args, LDS_BYTES, stream);
    if (e != hipSuccess) fprintf(stderr, "cooperative launch failed: %s (grid %d)\n", hipGetErrorString(e), grid_blocks);
}
```

```cpp
#include <hip/hip_runtime.h>
#include <hip/hip_cooperative_groups.h>
#include <cstdio>
#define DOUBLE_PHASE -1
namespace cg = cooperative_groups;

#define LAS __attribute__((address_space(3)))
typedef unsigned short bf16_t;
typedef short bf16x8 __attribute__((ext_vector_type(8)));
typedef float f32x4 __attribute__((ext_vector_type(4)));
typedef float f32x2 __attribute__((ext_vector_type(2)));
typedef unsigned u32x4 __attribute__((ext_vector_type(4)));
typedef unsigned u32x2 __attribute__((ext_vector_type(2)));

constexpr int DM = 2048, NBATCH = 4, SEQ = 2048, MP = NBATCH * SEQ, MS = 128, MT = MP + MS, MPAD = 8448;
constexpr int DQKV = 3072, NIN = 5136, NPROJ = 5120, NPADW = 5376, DFF = 8192;
constexpr int NCH = 1024;
constexpr float EPS = 1e-6f;

constexpr size_t OUT_Y = 0, OUT_GDN_P = 17039360, OUT_CONV_P = 17563648, OUT_POOL_P = 17600512, OUT_GDN_S = 17661952, OUT_CONV_S = 34439168, OUT_POOL_S = 35618816;

constexpr size_t WS_WUP = 0, WS_WDN = 33554432, WS_WIN = 67108864, WS_WOUT = 89128960, WS_WPOOL = 97517568, WS_AB = 98041856, WS_GL = 98582528,
                 WS_H = 98648064, WS_PROJ = 133251072, WS_GDN = 219758592;
constexpr size_t WS_W = WS_GDN, WS_QG = WS_W + 16777216, WS_KDT = WS_QG + 16777216, WS_INTRA = WS_KDT + 16777216, WS_U = WS_INTRA + 8388608, WS_GDN_END = WS_U + 33554432;
constexpr size_t WS_BAR = WS_GL + 8192;
constexpr size_t WS_SS = WS_GDN_END;
constexpr int KS5 = 8, KS8 = 16, KS7 = 4;
constexpr size_t WS_PART5 = WS_GDN;
constexpr size_t WS_PART8 = WS_H;
constexpr size_t WS_POOLED = WS_WIN;
constexpr size_t WS_MIX = WS_PROJ;
constexpr size_t WS_FF1 = WS_PROJ;
constexpr size_t WS_FF = WS_FF1 + (size_t)MPAD * DFF * 2;
constexpr size_t WS_PART7 = WS_FF;
constexpr size_t WS_X1 = WS_FF + (size_t)MP * DM * 2;
constexpr size_t WS_END = WS_X1 + (size_t)MT * DM * 2;
static_assert(WS_GDN_END <= WS_END && WS_FF >= WS_GDN_END - 50000000, "layout");

constexpr int LDS_BYTES = 147456;

struct Args { const float* in[19]; float* out; unsigned char* ws; };

typedef __bf16 bf16x2v __attribute__((ext_vector_type(2)));
__device__ __forceinline__ unsigned cvt_pk_bf16(float lo, float hi) { const f32x2 v = {lo, hi}; const bf16x2v r = __builtin_convertvector(v, bf16x2v); return __builtin_bit_cast(unsigned, r); }
__device__ __forceinline__ int otid() { int t = threadIdx.x; asm volatile("" : "+v"(t)); return t; }
__device__ __forceinline__ float bf_lo(unsigned u) { return __uint_as_float(u << 16); }
__device__ __forceinline__ float bf_hi(unsigned u) { return __uint_as_float(u & 0xffff0000u); }
__device__ __forceinline__ float bf1(bf16_t v) { return __uint_as_float(((unsigned)v) << 16); }
__device__ __forceinline__ float wave_sum(float v) {
#pragma unroll
    for (int o = 32; o >= 1; o >>= 1) v += __shfl_xor(v, o);
    return v;
}
__device__ __forceinline__ float silu_f(float x) { return x * __builtin_amdgcn_rcpf(1.0f + __expf(-x)); }
__device__ __forceinline__ float sigmoid_f(float x) { return __builtin_amdgcn_rcpf(1.0f + __expf(-x)); }
__device__ __forceinline__ float softplus_f(float x) { return fmaxf(x, 0.0f) + log1pf(__expf(-fabsf(x))); }

constexpr int BM = 256, BK = 64, HALF = 128, HTB = HALF * BK * 2, NXCD = 8, WGM = 8;
__device__ __forceinline__ int lds_byte(int r, int c) { const int st = (r >> 4) * 2 + (c >> 5), rr = r & 15, cc = c & 31, ob = rr * 64 + cc * 2; return st * 1024 + (ob ^ (((ob >> 9) & 1) << 5)); }
__device__ __forceinline__ void stage_rc(int b, int& R, int& C) { const int st = b / 1024, sb = b % 1024, swz = sb ^ (((sb >> 9) & 1) << 5); R = (st >> 1) * 16 + swz / 64; C = (st & 1) * 32 + (swz % 64) / 2; }
__device__ __forceinline__ int perm32(int rho) { const int n = rho >> 4, i = rho & 15; return 8 * (i >> 2) + 4 * n + (i & 3); }

struct Unit { int pm, pn, kt0, nt, part, ok; };
struct Gemm { const bf16_t* A; const bf16_t* Bt; int lda, ldb, K, a_pn_off, tm; };
struct StaticOrder {
    int nM, nN, nwg, G, c, ntk;
    __device__ __forceinline__ void init(int M, int N, int G_, int c_, int K) { nM = M / BM; nN = N / BM; nwg = nM * nN; G = G_; c = c_; ntk = K / BK; }
    __device__ __forceinline__ Unit unit_of(int L) const {
        int wgid = L; { const int q = nwg / NXCD, r = nwg % NXCD, xcd = wgid % NXCD, off = wgid / NXCD; wgid = (xcd < r ? xcd * (q + 1) : r * (q + 1) + (xcd - r) * q) + off; }
        const int nig = WGM * nN, gid = wgid / nig, fm = gid * WGM, gsz = (nM - fm) < WGM ? (nM - fm) : WGM;
        Unit u; u.pm = fm + ((wgid % nig) % gsz); u.pn = (wgid % nig) / gsz; u.kt0 = 0; u.nt = ntk; u.part = -1; u.ok = 1; return u;
    }
    __device__ __forceinline__ Unit next(int i) const { const int L = i * G + c; Unit u = unit_of(L < nwg ? L : 0); u.ok = L < nwg; return u; }
};
struct SplitOrder {
    StaticOrder m; int nsub, nts;
    __device__ __forceinline__ void init(int N, int G_, int c_, int K, int ksplit) { m.init(MP, N, G_, c_, K); nsub = m.nN * ksplit; nts = m.ntk / ksplit; }
    __device__ __forceinline__ Unit next(int i) const {
        const int L = i * m.G + m.c;
        Unit u = m.unit_of(L < m.nwg ? L : 0);
        const int s = L - m.nwg;
        if (s >= 0) { u.pm = MP / BM; u.pn = s % m.nN; u.part = s / m.nN; u.kt0 = u.part * nts; u.nt = nts; u.ok = s < nsub; }
        return u;
    }
};

struct EpiF32 {
    static constexpr bool PERM = false;
    float* C; int ldc; float* P;
    __device__ __forceinline__ void operator()(const f32x4 (&acc)[2][2][4][2], const Unit u, int wr, int wc, int fr, int fq) const {
        const int col0 = u.pn * BM + wc * 32 + 4 * fq;
        if (u.part < 0) {
            const int row0 = u.pm * BM + wr * 64 + fr;
#pragma unroll
            for (int ai = 0; ai < 2; ++ai)
#pragma unroll
                for (int m = 0; m < 4; ++m) { float* rowp = C + (size_t)(row0 + ai * HALF + m * 16) * ldc + col0;
#pragma unroll
                    for (int bj = 0; bj < 2; ++bj)
#pragma unroll
                        for (int n = 0; n < 2; ++n) *(f32x4*)(rowp + bj * HALF + n * 16) = acc[ai][bj][m][n]; }
        } else {
#pragma unroll
            for (int m = 0; m < 4; ++m) { float* rowp = P + ((size_t)u.part * 128 + wr * 64 + fr + m * 16) * ldc + col0;
#pragma unroll
                for (int bj = 0; bj < 2; ++bj)
#pragma unroll
                    for (int n = 0; n < 2; ++n) *(f32x4*)(rowp + bj * HALF + n * 16) = acc[0][bj][m][n]; }
        }
    }
};
template <int ACT> struct EpiBf16 {
    static constexpr bool PERM = true;
    bf16_t* O; int ldc; int coloff;
    __device__ __forceinline__ void operator()(const f32x4 (&acc)[2][2][4][2], const Unit u, int wr, int wc, int fr, int fq) const {
        const int row0 = u.pm * BM + wr * 64 + fr, col0 = coloff + u.pn * BM + wc * 32 + 8 * fq;
#pragma unroll
        for (int ai = 0; ai < 2; ++ai)
#pragma unroll
            for (int m = 0; m < 4; ++m) { bf16_t* rowp = O + (size_t)(row0 + ai * HALF + m * 16) * ldc + col0;
#pragma unroll
                for (int bj = 0; bj < 2; ++bj) { f32x4 v0 = acc[ai][bj][m][0], v1 = acc[ai][bj][m][1];
                    if (ACT == 1) {
#pragma unroll
                        for (int j = 0; j < 4; ++j) { const float a = fmaxf(v0[j], 0.f), b = fmaxf(v1[j], 0.f); v0[j] = a * a; v1[j] = b * b; } }
                    u32x4 w; w.x = cvt_pk_bf16(v0[0], v0[1]); w.y = cvt_pk_bf16(v0[2], v0[3]); w.z = cvt_pk_bf16(v1[0], v1[1]); w.w = cvt_pk_bf16(v1[2], v1[3]);
                    *(u32x4*)(rowp + bj * HALF) = w; } }
    }
};
template <int ACT, int TM = 0> struct EpiBf16P {
    static constexpr bool PERM = true;
    bf16_t* O; int ldc; float* P;
    __device__ __forceinline__ void operator()(const f32x4 (&acc)[2][2][4][2], const Unit u, int wr, int wc, int fr, int fq) const {
        const int col0 = u.pn * BM + wc * 32 + 8 * fq;
        if (u.part < 0) {
            const int row0 = u.pm * BM + wr * 64 + fr;
#pragma unroll
            for (int ai = 0; ai < 2; ++ai)
#pragma unroll
                for (int m = 0; m < 4; ++m) { bf16_t* rowp = TM ? O + (size_t)u.pm * ((size_t)ldc * BM) + (size_t)(u.pn * 4 + (wc >> 1)) * (BM * BK) + (size_t)(wr * 64 + fr + ai * HALF + m * 16) * BK + (wc & 1) * 32 + 8 * fq
                                                                    : O + (size_t)(row0 + ai * HALF + m * 16) * ldc + col0;
#pragma unroll
                    for (int bj = 0; bj < 2; ++bj) { f32x4 v0 = acc[ai][bj][m][0], v1 = acc[ai][bj][m][1];
                        if (ACT == 1) {
#pragma unroll
                            for (int j = 0; j < 4; ++j) { const float p = fmaxf(v0[j], 0.f), q = fmaxf(v1[j], 0.f); v0[j] = p * p; v1[j] = q * q; } }
                        u32x4 w; w.x = cvt_pk_bf16(v0[0], v0[1]); w.y = cvt_pk_bf16(v0[2], v0[3]); w.z = cvt_pk_bf16(v1[0], v1[1]); w.w = cvt_pk_bf16(v1[2], v1[3]);
                        *(u32x4*)(rowp + (TM ? bj * 2 * (BM * BK) : bj * HALF)) = w; } }
        } else {
#pragma unroll
            for (int m = 0; m < 4; ++m) { float* rowp = P + ((size_t)u.part * 128 + wr * 64 + fr + m * 16) * ldc + col0;
#pragma unroll
                for (int bj = 0; bj < 2; ++bj) { *(f32x4*)(rowp + bj * HALF) = acc[0][bj][m][0]; *(f32x4*)(rowp + bj * HALF + 4) = acc[0][bj][m][1]; } }
        }
    }
};
struct EpiProj {
    static constexpr bool PERM = true;
    bf16_t* O; float* AB;
    __device__ __forceinline__ void operator()(const f32x4 (&acc)[2][2][4][2], const Unit u, int wr, int wc, int fr, int fq) const {
        const int row0 = u.pm * BM + wr * 64 + fr;
        if (u.pn < 20) {
            const int col0 = u.pn * BM + wc * 32 + 8 * fq;
#pragma unroll
            for (int ai = 0; ai < 2; ++ai)
#pragma unroll
                for (int m = 0; m < 4; ++m) { bf16_t* rowp = O + (size_t)(row0 + ai * HALF + m * 16) * NPROJ + col0;
#pragma unroll
                    for (int bj = 0; bj < 2; ++bj) { const f32x4 v0 = acc[ai][bj][m][0], v1 = acc[ai][bj][m][1];
                        u32x4 w; w.x = cvt_pk_bf16(v0[0], v0[1]); w.y = cvt_pk_bf16(v0[2], v0[3]); w.z = cvt_pk_bf16(v1[0], v1[1]); w.w = cvt_pk_bf16(v1[2], v1[3]);
                        *(u32x4*)(rowp + bj * HALF) = w; } }
        } else if (wc == 0 && fq < 2) {
#pragma unroll
            for (int ai = 0; ai < 2; ++ai)
#pragma unroll
                for (int m = 0; m < 4; ++m) { float* rowp = AB + (size_t)(row0 + ai * HALF + m * 16) * 16 + 8 * fq;
                    *(f32x4*)(rowp) = acc[ai][0][m][0]; *(f32x4*)(rowp + 4) = acc[ai][0][m][1]; }
        }
    }
};

template <class Epi, class Sched>
__device__ __forceinline__ void gemm_phase(LAS unsigned char* lds, const Gemm g, const Sched& S, const Epi& E) {
    const int tid = otid(), wid = __builtin_amdgcn_readfirstlane(tid >> 6), lane = tid & 63, wr = wid >> 2, wc = wid & 3, fr = lane & 15, fq = lane >> 4;
    unsigned voffA[2], voffB[2];
#pragma unroll
    for (int i = 0; i < 2; ++i) { int R, C; stage_rc(tid * 16 + i * 8192, R, C); const int Rb = Epi::PERM ? ((R & ~31) + perm32(R & 31)) : R;
        voffA[i] = (unsigned)(R * g.lda + C) * 2u; voffB[i] = (unsigned)(Rb * g.ldb + C) * 2u; }
    const size_t kstepA = g.tm ? (size_t)BM * BK * 2 : (size_t)(BK * 2), kstepB = kstepA;
    const size_t hstepA = (size_t)HALF * g.lda * 2, hstepB = (size_t)HALF * g.ldb * 2;
    const size_t tstepA = g.tm ? (size_t)(g.K / BK) * BM * BK * 2 : 2 * hstepA, tstepB = g.tm ? tstepA : 2 * hstepB;
    const unsigned ldsw = (unsigned)wid * 1024u;
    const int aoff = lds_byte(wr * 64 + fr, fq * 8), boff = lds_byte(wc * 32 + fr, fq * 8);
#define PG8_SA(b, h) (((b) * 2 + (h)) * HTB)
#define PG8_SB(b, h) ((4 + (b) * 2 + (h)) * HTB)
#define PG8_STAGE(bufoff, gbase, voff) do { _Pragma("unroll") for (int _i = 0; _i < 2; ++_i) \
        __builtin_amdgcn_global_load_lds((const unsigned*)((const char*)(gbase) + (voff)[_i]), (LAS unsigned*)(lds + (bufoff) + ldsw + _i * 8192), 16, 0, 0); } while (0)
#define PG8_LDA(dst, b, h) do { _Pragma("unroll") for (int m = 0; m < 4; ++m) _Pragma("unroll") for (int k = 0; k < 2; ++k) dst[m][k] = *(const LAS bf16x8*)(lds + PG8_SA(b, h) + aoff + m * 2048 + k * 1024); } while (0)
#define PG8_LDB(dst, b, h) do { _Pragma("unroll") for (int n = 0; n < 2; ++n) _Pragma("unroll") for (int k = 0; k < 2; ++k) dst[n][k] = *(const LAS bf16x8*)(lds + PG8_SB(b, h) + boff + n * 2048 + k * 1024); } while (0)
#define PG8_MMA(ai, bj, At, Bt) do { __builtin_amdgcn_s_setprio(1); _Pragma("unroll") for (int m = 0; m < 4; ++m) _Pragma("unroll") for (int n = 0; n < 2; ++n) _Pragma("unroll") for (int k = 0; k < 2; ++k) \
        acc[ai][bj][m][n] = __builtin_amdgcn_mfma_f32_16x16x32_bf16(Bt[n][k], At[m][k], acc[ai][bj][m][n], 0, 0, 0); __builtin_amdgcn_s_setprio(0); } while (0)
#define PG8_WAIT_V(n) asm volatile("s_waitcnt vmcnt(" #n ")" ::: "memory")
#define PG8_WAIT_L(n) asm volatile("s_waitcnt lgkmcnt(" #n ")" ::: "memory")
#define PG8_BAR __builtin_amdgcn_s_barrier()
#define PG8_SCHED __builtin_amdgcn_sched_barrier(0)
    Unit cur = S.next(0); int ui = 0;
    if (!cur.ok) return;
    f32x4 acc[2][2][4][2];
#pragma unroll
    for (int a = 0; a < 2; ++a)
#pragma unroll
        for (int b = 0; b < 2; ++b)
#pragma unroll
            for (int m = 0; m < 4; ++m)
#pragma unroll
                for (int n = 0; n < 2; ++n) acc[a][b][m][n] = (f32x4){0.f, 0.f, 0.f, 0.f};
    bf16x8 At[4][2], B0[2][2], B1[2][2];
    const char* cA = (const char*)g.A + (size_t)cur.pm * tstepA + (size_t)cur.pn * g.a_pn_off * 2 + (size_t)cur.kt0 * kstepA; const char* cB = (const char*)g.Bt + (size_t)cur.pn * tstepB + (size_t)cur.kt0 * kstepB;
    PG8_STAGE(PG8_SB(0, 0), cB, voffB); PG8_STAGE(PG8_SA(0, 0), cA, voffA); PG8_STAGE(PG8_SB(0, 1), cB + hstepB, voffB); PG8_STAGE(PG8_SA(0, 1), cA + hstepA, voffA);
    if (wr == 1) PG8_BAR;
    PG8_WAIT_V(4); PG8_BAR;
    PG8_STAGE(PG8_SB(1, 0), cB + kstepB, voffB); PG8_STAGE(PG8_SA(1, 0), cA + kstepA, voffA); PG8_STAGE(PG8_SB(1, 1), cB + hstepB + kstepB, voffB);
    PG8_WAIT_V(6); PG8_BAR;
    for (;;) {
        const Unit nxt = S.next(ui + 1); const bool has_next = nxt.ok != 0;
        const char* nA = has_next ? (const char*)g.A + (size_t)nxt.pm * tstepA + (size_t)nxt.pn * g.a_pn_off * 2 + (size_t)nxt.kt0 * kstepA : cA; const char* nB = has_next ? (const char*)g.Bt + (size_t)nxt.pn * tstepB + (size_t)nxt.kt0 * kstepB : cB;
        const int nt = cur.nt;
        for (int t = 0; t < nt; t += 2) {
            const bool last = (t == nt - 2);
            const char* a1 = cA + (size_t)(t + 1) * kstepA;
            const char* a2 = last ? nA : cA + (size_t)(t + 2) * kstepA; const char* b2 = last ? nB : cB + (size_t)(t + 2) * kstepB;
            const char* a3 = a2 + kstepA; const char* b3 = b2 + kstepB;
            PG8_LDB(B0, 0, 0); PG8_SCHED; PG8_LDA(At, 0, 0); PG8_STAGE(PG8_SA(1, 1), a1 + hstepA, voffA);
            PG8_WAIT_L(8); PG8_BAR; PG8_WAIT_L(0); PG8_MMA(0, 0, At, B0); PG8_BAR; PG8_SCHED;
            PG8_LDB(B1, 0, 1); PG8_STAGE(PG8_SB(0, 0), b2, voffB);
            PG8_BAR; PG8_WAIT_L(0); PG8_MMA(0, 1, At, B1); PG8_BAR;
            PG8_LDA(At, 0, 1); PG8_STAGE(PG8_SA(0, 0), a2, voffA);
            PG8_BAR; PG8_WAIT_L(0); PG8_MMA(1, 0, At, B0); PG8_BAR; PG8_SCHED;
            PG8_STAGE(PG8_SB(0, 1), b2 + hstepB, voffB);
            PG8_WAIT_V(6); PG8_BAR; PG8_MMA(1, 1, At, B1); PG8_BAR;
            PG8_LDB(B0, 1, 0); PG8_SCHED; PG8_LDA(At, 1, 0); PG8_STAGE(PG8_SA(0, 1), a2 + hstepA, voffA);
            PG8_WAIT_L(8); PG8_BAR; PG8_WAIT_L(0); PG8_MMA(0, 0, At, B0); PG8_BAR; PG8_SCHED;
            PG8_LDB(B1, 1, 1); PG8_STAGE(PG8_SB(1, 0), b3, voffB);
            PG8_BAR; PG8_WAIT_L(0); PG8_MMA(0, 1, At, B1); PG8_BAR;
            PG8_LDA(At, 1, 1); PG8_STAGE(PG8_SA(1, 0), a3, voffA);
            PG8_BAR; PG8_WAIT_L(0); PG8_MMA(1, 0, At, B0); PG8_BAR; PG8_SCHED;
            PG8_STAGE(PG8_SB(1, 1), b3 + hstepB, voffB);
            PG8_WAIT_V(6); PG8_BAR; PG8_MMA(1, 1, At, B1); PG8_BAR;
        }
        E(acc, cur, wr, wc, fr, fq);
        if (!has_next) break;
#pragma unroll
        for (int a = 0; a < 2; ++a)
#pragma unroll
            for (int b = 0; b < 2; ++b)
#pragma unroll
                for (int m = 0; m < 4; ++m)
#pragma unroll
                    for (int n = 0; n < 2; ++n) acc[a][b][m][n] = (f32x4){0.f, 0.f, 0.f, 0.f};
        cur = nxt; cA = nA; cB = nB; ++ui;
    }
    PG8_WAIT_V(0);
    if (wr == 0) PG8_BAR;
    PG8_BAR;
#undef PG8_SA
#undef PG8_SB
#undef PG8_STAGE
#undef PG8_LDA
#undef PG8_LDB
#undef PG8_MMA
#undef PG8_WAIT_V
#undef PG8_WAIT_L
#undef PG8_BAR
#undef PG8_SCHED
}

struct TDesc { const float* src; const float* scale; bf16_t* dst; int ld_src, k0, sc0, nv, ld_dst, n0, dk0; };
constexpr int TL_WIN = 0, TL_WOUT = 32 * 21, TL_WUP = TL_WOUT + 32 * 8, TL_WDN = TL_WUP + 32 * 32, TL_WPOOL = TL_WDN + 128 * 8, TL_END = TL_WPOOL + 16;
__device__ __forceinline__ TDesc tile_desc(const Args& a, int t) {
    unsigned char* ws = a.ws; TDesc d; d.scale = nullptr; d.nv = 256; d.dk0 = -1;
    if (t < TL_WOUT) { const int kt = t / 21, nt = t % 21, n0 = nt * 256;
        int sc0; if (n0 < 4096) sc0 = n0; else if (n0 < 5120) sc0 = n0 + 16; else { sc0 = 4096; d.nv = 16; }
        d.src = a.in[6]; d.ld_src = NIN; d.k0 = kt * 64; d.sc0 = sc0; d.dst = (bf16_t*)(ws + WS_WIN); d.ld_dst = DM; d.n0 = n0;
    } else if (t < TL_WUP) { const int u = t - TL_WOUT, kt = u / 8, nt = u % 8;
        d.src = a.in[13]; d.ld_src = DM; d.k0 = kt * 64; d.sc0 = nt * 256; d.dst = (bf16_t*)(ws + WS_WOUT); d.ld_dst = DM; d.n0 = nt * 256;
    } else if (t < TL_WDN) { const int u = t - TL_WUP, kt = u / 32, nt = u % 32;
        d.src = a.in[16]; d.ld_src = DFF; d.k0 = kt * 64; d.sc0 = nt * 256; d.dst = (bf16_t*)(ws + WS_WUP); d.ld_dst = DM; d.n0 = nt * 256;
    } else if (t < TL_WPOOL) { const int u = t - TL_WDN, kt = u / 8, nt = u % 8;
        d.src = a.in[17]; d.ld_src = DM; d.k0 = kt * 64; d.sc0 = nt * 256; d.dst = (bf16_t*)(ws + WS_WDN) + (size_t)nt * ((size_t)DFF * BM) + (size_t)kt * (BM * BK); d.ld_dst = BK; d.n0 = 0; d.dk0 = 0;
    } else { const int u = t - TL_WPOOL, g = u >> 2, kt = u & 3;
        d.src = a.in[11] + (size_t)g * 65536; d.ld_src = 256; d.k0 = kt * 64; d.sc0 = 0; d.dst = (bf16_t*)(ws + WS_WPOOL) + (size_t)g * 65536; d.ld_dst = 256; d.n0 = 0; d.scale = a.in[12] + g * 256;
    }
    if (d.dk0 < 0) d.dk0 = d.k0;
    return d;
}
__device__ __forceinline__ void convert_tiles(const Args& a, LAS unsigned char* lds, int t_lo, int t_hi, int first, int stride) {
    LAS float* tile = (LAS float*)lds;
    const int tid = otid();
    int t = t_lo + first;
    TDesc d = tile_desc(a, t < t_hi ? t : t_lo);
    f32x4 v[8];
#pragma unroll
    for (int i = 0; i < 8; ++i) { const int idx = tid + i * 512, r = idx >> 6, c4 = (idx & 63) * 4;
        v[i] = (f32x4){0.f, 0.f, 0.f, 0.f}; if (t < t_hi && c4 < d.nv) v[i] = __builtin_nontemporal_load((const f32x4*)(d.src + (size_t)(d.k0 + r) * d.ld_src + d.sc0 + c4)); }
    while (t < t_hi) {
#pragma unroll
        for (int i = 0; i < 8; ++i) { const int idx = tid + i * 512, r = idx >> 6, c4 = (idx & 63) * 4; *(LAS f32x4*)(tile + r * 260 + c4) = v[i]; }
        __syncthreads();
        const int tn = t + stride;
        const TDesc dn = tile_desc(a, tn < t_hi ? tn : t_lo);
#pragma unroll
        for (int i = 0; i < 8; ++i) { const int idx = tid + i * 512, r = idx >> 6, c4 = (idx & 63) * 4;
            v[i] = (f32x4){0.f, 0.f, 0.f, 0.f}; if (tn < t_hi && c4 < dn.nv) v[i] = __builtin_nontemporal_load((const f32x4*)(dn.src + (size_t)(dn.k0 + r) * dn.ld_src + dn.sc0 + c4)); }
#pragma unroll
        for (int j = 0; j < 4; ++j) {
            const int item = tid + j * 512, n = item >> 3, k8 = item & 7;
            const float sc = d.scale ? d.scale[n] : 1.0f;
            float x[8];
#pragma unroll
            for (int jj = 0; jj < 8; ++jj) x[jj] = tile[(k8 * 8 + jj) * 260 + n] * sc;
            u32x4 w; w.x = cvt_pk_bf16(x[0], x[1]); w.y = cvt_pk_bf16(x[2], x[3]); w.z = cvt_pk_bf16(x[4], x[5]); w.w = cvt_pk_bf16(x[6], x[7]);
            *(u32x4*)(d.dst + (size_t)(d.n0 + n) * d.ld_dst + d.dk0 + k8 * 8) = w;
        }
        __syncthreads();
        t = tn; d = dn;
    }
}
__device__ __forceinline__ void convert_on_idle(const Args& a, LAS unsigned char* lds, int cblk, int lo, int t_lo, int t_hi) {
    const int G = (int)gridDim.x;
    if (G > lo) { if (cblk >= lo) convert_tiles(a, lds, t_lo, t_hi, cblk - lo, G - lo); }
    else convert_tiles(a, lds, t_lo, t_hi, cblk, G);
}

__device__ __forceinline__ void phase0(const Args& a, LAS unsigned char* lds) {
    unsigned char* ws = a.ws;
    convert_tiles(a, lds, TL_WIN, TL_WOUT, (int)blockIdx.x, (int)gridDim.x);
    convert_tiles(a, lds, TL_WPOOL, TL_END, (int)blockIdx.x, (int)gridDim.x);
    const int tid0 = otid(), lane = tid0 & 63, gw = blockIdx.x * 8 + (tid0 >> 6), nw = gridDim.x * 8;
    const float* nw_pre = a.in[5];
    bf16_t* H = (bf16_t*)(ws + WS_H);
    f32x4 vn[8];
    {   const int r0 = gw < MT ? gw : 0; const float* x0 = r0 < MP ? a.in[0] + (size_t)r0 * DM : a.in[1] + (size_t)(r0 - MP) * DM;
#pragma unroll
        for (int i = 0; i < 8; ++i) vn[i] = __builtin_nontemporal_load((const f32x4*)(x0 + (i * 64 + lane) * 4)); }
    for (int row = gw; row < MT; row += nw) {
        f32x4 v[8]; float ss = 0.f;
#pragma unroll
        for (int i = 0; i < 8; ++i) { v[i] = vn[i]; ss += v[i][0] * v[i][0] + v[i][1] * v[i][1] + v[i][2] * v[i][2] + v[i][3] * v[i][3]; }
        {   const int rn = row + nw < MT ? row + nw : row; const float* xn = rn < MP ? a.in[0] + (size_t)rn * DM : a.in[1] + (size_t)(rn - MP) * DM;
#pragma unroll
            for (int i = 0; i < 8; ++i) vn[i] = __builtin_nontemporal_load((const f32x4*)(xn + (i * 64 + lane) * 4)); }
        ss = wave_sum(ss);
        const float rs = rsqrtf(ss * (1.0f / DM) + EPS);
#pragma unroll
        for (int i = 0; i < 8; ++i) { const f32x4 w = *(const f32x4*)(nw_pre + (i * 64 + lane) * 4);
            u32x2 o; o.x = cvt_pk_bf16(v[i][0] * rs * w[0], v[i][1] * rs * w[1]); o.y = cvt_pk_bf16(v[i][2] * rs * w[2], v[i][3] * rs * w[3]);
            *(u32x2*)(H + (size_t)row * DM + (i * 64 + lane) * 4) = o; }
    }
}

constexpr int GRP_LDS = 70656, G_QB = 0, G_KB = 17408, G_VB = 34816, G_LM = 52224, G_GC = 69632, G_BETA = 69888, G_EGC = 70144, ROWB = 272;

__device__ __forceinline__ void gdn_chunk_prep(const Args& a, LAS unsigned char* lds) {
    const int tid = otid(), grp = tid >> 8, gt = tid & 255, gw = gt >> 6, lane = tid & 63, fr = lane & 15, fq = lane >> 4;
    LAS unsigned char* L = lds + grp * GRP_LDS;
    LAS float* gcs = (LAS float*)(L + G_GC); LAS float* betas = (LAS float*)(L + G_BETA); LAS float* egc = (LAS float*)(L + G_EGC); LAS float* Lm = (LAS float*)(L + G_LM);
    unsigned char* ws = a.ws;
    const bf16_t* PROJ = (const bf16_t*)(ws + WS_PROJ); const float* AB = (const float*)(ws + WS_AB);
    bf16_t* Wg = (bf16_t*)(ws + WS_W); bf16_t* QG = (bf16_t*)(ws + WS_QG); bf16_t* KDT = (bf16_t*)(ws + WS_KDT); bf16_t* INTRA = (bf16_t*)(ws + WS_INTRA); float* U = (float*)(ws + WS_U); float* GL = (float*)(ws + WS_GL);
    const float* convw = a.in[7];
    const int stride = gridDim.x * 2, niter = (NCH + stride - 1) / stride;
    for (int it = 0; it < niter; ++it) {
        const int cidx = it * stride + blockIdx.x * 2 + grp;
        const bool active = cidx < NCH;
        const int bh = cidx >> 5, n = cidx & 31, b = bh >> 3, h = bh & 7;
        const size_t row0 = (size_t)b * SEQ + n * 64;
        if (active) {
            const float av = AB[(row0 + lane) * 16 + h], bv = AB[(row0 + lane) * 16 + 8 + h];
            const int cq = h * 128 + 2 * lane;
            float cw[4][3][2];
#pragma unroll
            for (int j = 0; j < 4; ++j)
#pragma unroll
                for (int p = 0; p < 3; ++p) { const f32x2 w2 = *(const f32x2*)(convw + j * DQKV + p * 1024 + cq); cw[j][p][0] = w2[0]; cw[j][p][1] = w2[1]; }
            float xw[3][3][2];
            const int p0 = n * 64 + gw * 16;
#pragma unroll
            for (int j = 0; j < 3; ++j) { const int p = p0 - 3 + j;
#pragma unroll
                for (int q = 0; q < 3; ++q) { unsigned u = *(const unsigned*)(PROJ + ((size_t)b * SEQ + (p >= 0 ? p : 0)) * NPROJ + q * 1024 + cq); u = p >= 0 ? u : 0u; xw[j][q][0] = bf_lo(u); xw[j][q][1] = bf_hi(u); } }
            unsigned raw[16][3];
#pragma unroll
            for (int tt = 0; tt < 16; ++tt)
#pragma unroll
                for (int q = 0; q < 3; ++q) raw[tt][q] = __builtin_nontemporal_load((const unsigned*)(PROJ + (row0 + gw * 16 + tt) * NPROJ + q * 1024 + cq));
#pragma unroll
            for (int tg = 0; tg < 4; ++tg) {
                float y[4][3][2], red[8];
#pragma unroll
                for (int t4 = 0; t4 < 4; ++t4) {
#pragma unroll
                    for (int q = 0; q < 3; ++q) { const unsigned u = raw[tg * 4 + t4][q]; const float c0 = bf_lo(u), c1 = bf_hi(u);
                        float y0 = cw[0][q][0] * xw[0][q][0] + cw[1][q][0] * xw[1][q][0] + cw[2][q][0] * xw[2][q][0] + cw[3][q][0] * c0;
                        float y1 = cw[0][q][1] * xw[0][q][1] + cw[1][q][1] * xw[1][q][1] + cw[2][q][1] * xw[2][q][1] + cw[3][q][1] * c1;
                        xw[0][q][0] = xw[1][q][0]; xw[0][q][1] = xw[1][q][1]; xw[1][q][0] = xw[2][q][0]; xw[1][q][1] = xw[2][q][1]; xw[2][q][0] = c0; xw[2][q][1] = c1;
                        y[t4][q][0] = silu_f(y0); y[t4][q][1] = silu_f(y1); }
                    red[t4 * 2 + 0] = y[t4][0][0] * y[t4][0][0] + y[t4][0][1] * y[t4][0][1];
                    red[t4 * 2 + 1] = y[t4][1][0] * y[t4][1][0] + y[t4][1][1] * y[t4][1][1];
                }
#pragma unroll
                for (int o = 32; o >= 1; o >>= 1)
#pragma unroll
                    for (int k = 0; k < 8; ++k) red[k] += __shfl_xor(red[k], o);
#pragma unroll
                for (int t4 = 0; t4 < 4; ++t4) { const int i = gw * 16 + tg * 4 + t4;
                    const float rq = rsqrtf(red[t4 * 2] + EPS) * 0.08838834764831845f, rk = rsqrtf(red[t4 * 2 + 1] + EPS);
                    *(LAS unsigned*)(L + G_QB + i * ROWB + lane * 4) = cvt_pk_bf16(y[t4][0][0] * rq, y[t4][0][1] * rq);
                    *(LAS unsigned*)(L + G_KB + i * ROWB + lane * 4) = cvt_pk_bf16(y[t4][1][0] * rk, y[t4][1][1] * rk);
                    *(LAS unsigned*)(L + G_VB + i * ROWB + lane * 4) = cvt_pk_bf16(y[t4][2][0], y[t4][2][1]); }
            }
            if (gw == 0) {
                float gv = -__expf(a.in[8][h]) * softplus_f(av + a.in[9][h]);
#pragma unroll
                for (int o = 1; o < 64; o <<= 1) { const float t = __shfl_up(gv, o); if (lane >= o) gv += t; }
                gcs[lane] = gv; betas[lane] = sigmoid_f(bv); egc[lane] = __expf(gv);
            }
        }
        __syncthreads();
        if (active) {
            const int I = gw, i = 16 * I + fr;
            bf16x8 bK[4], bQ[4];
#pragma unroll
            for (int ks = 0; ks < 4; ++ks) { bK[ks] = *(const LAS bf16x8*)(L + G_KB + i * ROWB + ks * 64 + fq * 16); bQ[ks] = *(const LAS bf16x8*)(L + G_QB + i * ROWB + ks * 64 + fq * 16); }
            const float gci = gcs[i], bi = betas[i];
            for (int J = 0; J < 4; ++J) {
                u32x2 iv = (u32x2){0u, 0u};
                if (J <= I) {
                    f32x4 ck = (f32x4){0.f, 0.f, 0.f, 0.f}, cq2 = ck;
#pragma unroll
                    for (int ks = 0; ks < 4; ++ks) { const bf16x8 af = *(const LAS bf16x8*)(L + G_KB + (16 * J + fr) * ROWB + ks * 64 + fq * 16);
                        ck = __builtin_amdgcn_mfma_f32_16x16x32_bf16(af, bK[ks], ck, 0, 0, 0); cq2 = __builtin_amdgcn_mfma_f32_16x16x32_bf16(af, bQ[ks], cq2, 0, 0, 0); }
                    const f32x4 gj = *(const LAS f32x4*)(gcs + 16 * J + 4 * fq);
                    f32x4 lv; float ivf[4];
#pragma unroll
                    for (int r = 0; r < 4; ++r) { const int j = 16 * J + 4 * fq + r; const float dec = (j <= i) ? __expf(fminf(gci - gj[r], 0.f)) : 0.f;
                        lv[r] = (j < i) ? bi * ck[r] * dec : 0.f; ivf[r] = cq2[r] * dec; }
                    *(LAS f32x4*)(Lm + i * 68 + 16 * J + 4 * fq) = lv;
                    iv.x = cvt_pk_bf16(ivf[0], ivf[1]); iv.y = cvt_pk_bf16(ivf[2], ivf[3]);
                }
                *(u32x2*)(INTRA + (size_t)cidx * 4096 + ((I * 2 + (J >> 1)) * 64 + ((J & 1) * 2 + (fq >> 1)) * 16 + fr) * 8 + (fq & 1) * 4) = iv;
            }
            const float glast = gcs[63];
#pragma unroll
            for (int r = 0; r < 4; ++r) { const int item = gt + r * 256, ti = item >> 4, d8 = item & 15;
                const u32x4 qv = *(const LAS u32x4*)(L + G_QB + ti * ROWB + d8 * 16); const float e = egc[ti];
                u32x4 o; o.x = cvt_pk_bf16(bf_lo(qv.x) * e, bf_hi(qv.x) * e); o.y = cvt_pk_bf16(bf_lo(qv.y) * e, bf_hi(qv.y) * e); o.z = cvt_pk_bf16(bf_lo(qv.z) * e, bf_hi(qv.z) * e); o.w = cvt_pk_bf16(bf_lo(qv.w) * e, bf_hi(qv.w) * e);
                *(u32x4*)(QG + (size_t)cidx * 8192 + (((ti >> 4) * 4 + (d8 >> 2)) * 64 + (d8 & 3) * 16 + (ti & 15)) * 8) = o; }
#pragma unroll
            for (int r = 0; r < 4; ++r) { const int item = gt + r * 256, d = item & 127, i8 = item >> 7;
                float v[8];
#pragma unroll
                for (int j = 0; j < 8; ++j) { const int ti = i8 * 8 + j; v[j] = bf1(*(const LAS bf16_t*)(L + G_KB + ti * ROWB + d * 2)) * __expf(glast - gcs[ti]); }
                u32x4 o; o.x = cvt_pk_bf16(v[0], v[1]); o.y = cvt_pk_bf16(v[2], v[3]); o.z = cvt_pk_bf16(v[4], v[5]); o.w = cvt_pk_bf16(v[6], v[7]);
                *(u32x4*)(KDT + (size_t)cidx * 8192 + (((d >> 4) * 2 + (i8 >> 2)) * 64 + (i8 & 3) * 16 + (d & 15)) * 8) = o; }
            if (gt == 0) GL[cidx] = __expf(glast);
        }
        __syncthreads();
        if (active) {
            {
                const bool isw = gt >= 128; const int col = gt & 127;
                const LAS unsigned char* srcp = L + (isw ? G_KB : G_VB) + col * 2;
                float x[64];
#pragma unroll
                for (int i = 0; i < 64; ++i) {
                    f32x4 lq[16];
#pragma unroll
                    for (int q = 0; q < (i + 3) / 4; ++q) lq[q] = *(const LAS f32x4*)(Lm + i * 68 + q * 4);
                    float r0 = bf1(*(const LAS bf16_t*)(srcp + i * ROWB)) * betas[i];
                    if (isw) r0 *= egc[i];
                    float ac0 = r0, ac1 = 0.f, ac2 = 0.f, ac3 = 0.f;
#pragma unroll
                    for (int q = 0; q < (i + 3) / 4; ++q) {
                        if (q * 4 + 0 < i) ac0 -= lq[q][0] * x[q * 4 + 0];
                        if (q * 4 + 1 < i) ac1 -= lq[q][1] * x[q * 4 + 1];
                        if (q * 4 + 2 < i) ac2 -= lq[q][2] * x[q * 4 + 2];
                        if (q * 4 + 3 < i) ac3 -= lq[q][3] * x[q * 4 + 3];
                    }
                    const float acc = (ac0 + ac1) + (ac2 + ac3);
                    x[i] = acc;
                    if (isw) Wg[(size_t)cidx * 8192 + (((i >> 4) * 4 + (col >> 5)) * 64 + ((col >> 3) & 3) * 16 + (i & 15)) * 8 + (col & 7)] = (bf16_t)(cvt_pk_bf16(acc, 0.f) & 0xffffu);
                    else if ((i & 3) == 3) *(f32x4*)(U + (size_t)cidx * 8192 + (col >> 4) * 1024 + (i >> 4) * 256 + ((((i >> 2) & 3) * 16 + (col & 15)) * 4)) = (f32x4){x[i - 3], x[i - 2], x[i - 1], acc};
                }
            }
        }
        __syncthreads();
    }
}

template <int WIN>
__device__ __forceinline__ void pool_prompt_group(const bf16_t* PROJ, bf16_t* POOLED, int g, size_t gtid, size_t gsz) {
    for (size_t item = gtid; item < (size_t)MP * 32; item += gsz) {
        const int t = (int)(item >> 5), c8 = g * 32 + (int)(item & 31), p = t & (SEQ - 1);
        const int cnt = (p + 1) < WIN ? (p + 1) : WIN;
        u32x4 v[WIN];
#pragma unroll
        for (int j = 0; j < WIN; ++j) { const int jj = j < cnt ? j : 0; v[j] = *(const u32x4*)(PROJ + (size_t)(t - jj) * NPROJ + 4096 + c8 * 8); }
        float s[8] = {0.f, 0.f, 0.f, 0.f, 0.f, 0.f, 0.f, 0.f};
#pragma unroll
        for (int j = 0; j < WIN; ++j) { const float m = j < cnt ? 1.0f : 0.0f;
            s[0] += m * bf_lo(v[j].x); s[1] += m * bf_hi(v[j].x); s[2] += m * bf_lo(v[j].y); s[3] += m * bf_hi(v[j].y);
            s[4] += m * bf_lo(v[j].z); s[5] += m * bf_hi(v[j].z); s[6] += m * bf_lo(v[j].w); s[7] += m * bf_hi(v[j].w); }
        const float cur[8] = {bf_lo(v[0].x), bf_hi(v[0].x), bf_lo(v[0].y), bf_hi(v[0].y), bf_lo(v[0].z), bf_hi(v[0].z), bf_lo(v[0].w), bf_hi(v[0].w)};
        const float inv = 1.0f / (float)cnt;
        u32x4 o; o.x = cvt_pk_bf16(s[0] * inv - cur[0], s[1] * inv - cur[1]); o.y = cvt_pk_bf16(s[2] * inv - cur[2], s[3] * inv - cur[3]);
        o.z = cvt_pk_bf16(s[4] * inv - cur[4], s[5] * inv - cur[5]); o.w = cvt_pk_bf16(s[6] * inv - cur[6], s[7] * inv - cur[7]);
        *(u32x4*)(POOLED + (size_t)t * 1024 + c8 * 8) = o;
    }
}
template <int WIN>
__device__ __forceinline__ void pool_sample_group(const bf16_t* PROJ, const float* spool, bf16_t* POOLED, int g, size_t gtid, size_t gsz) {
    for (size_t item = gtid; item < (size_t)MS * 32; item += gsz) {
        const int b = (int)(item >> 5), c8 = g * 32 + (int)(item & 31);
        const u32x4 v = *(const u32x4*)(PROJ + (size_t)(MP + b) * NPROJ + 4096 + c8 * 8);
        f32x4 r0[WIN - 1], r1[WIN - 1];
#pragma unroll
        for (int j = 1; j < WIN; ++j) { const float* r = spool + ((size_t)b * 15 + (15 - j)) * 1024 + c8 * 8; r0[j - 1] = *(const f32x4*)r; r1[j - 1] = *(const f32x4*)(r + 4); }
        const float cur[8] = {bf_lo(v.x), bf_hi(v.x), bf_lo(v.y), bf_hi(v.y), bf_lo(v.z), bf_hi(v.z), bf_lo(v.w), bf_hi(v.w)};
        float s[8];
#pragma unroll
        for (int k = 0; k < 8; ++k) s[k] = cur[k];
#pragma unroll
        for (int j = 0; j < WIN - 1; ++j) { s[0] += r0[j][0]; s[1] += r0[j][1]; s[2] += r0[j][2]; s[3] += r0[j][3]; s[4] += r1[j][0]; s[5] += r1[j][1]; s[6] += r1[j][2]; s[7] += r1[j][3]; }
        const float inv = 1.0f / (float)WIN;
        u32x4 o; o.x = cvt_pk_bf16(s[0] * inv - cur[0], s[1] * inv - cur[1]); o.y = cvt_pk_bf16(s[2] * inv - cur[2], s[3] * inv - cur[3]);
        o.z = cvt_pk_bf16(s[4] * inv - cur[4], s[5] * inv - cur[5]); o.w = cvt_pk_bf16(s[6] * inv - cur[6], s[7] * inv - cur[7]);
        *(u32x4*)(POOLED + (size_t)(MP + b) * 1024 + c8 * 8) = o;
    }
}
__device__ __forceinline__ f32x4 bf4_to_f32(u32x2 u) { return (f32x4){bf_lo(u.x), bf_hi(u.x), bf_lo(u.y), bf_hi(u.y)}; }
__device__ __forceinline__ void pool_and_copies(const Args& a) {
    unsigned char* ws = a.ws;
    const bf16_t* PROJ = (const bf16_t*)(ws + WS_PROJ); bf16_t* POOLED = (bf16_t*)(ws + WS_POOLED);
    const size_t gtid = (size_t)blockIdx.x * 512 + otid(), gsz = (size_t)gridDim.x * 512;
    const float* spool = a.in[4]; const float* sconv = a.in[3];
    pool_prompt_group<2>(PROJ, POOLED, 0, gtid, gsz); pool_prompt_group<4>(PROJ, POOLED, 1, gtid, gsz);
    pool_prompt_group<8>(PROJ, POOLED, 2, gtid, gsz); pool_prompt_group<16>(PROJ, POOLED, 3, gtid, gsz);
    pool_sample_group<2>(PROJ, spool, POOLED, 0, gtid, gsz); pool_sample_group<4>(PROJ, spool, POOLED, 1, gtid, gsz);
    pool_sample_group<8>(PROJ, spool, POOLED, 2, gtid, gsz); pool_sample_group<16>(PROJ, spool, POOLED, 3, gtid, gsz);
    float* out = a.out;
    for (size_t e = gtid; e < (size_t)NBATCH * 15 * 256; e += gsz) { const int c4 = (int)(e & 255) * 4, r = (int)((e >> 8) % 15), b = (int)(e / (15 * 256));
        __builtin_nontemporal_store(bf4_to_f32(*(const u32x2*)(PROJ + ((size_t)b * SEQ + SEQ - 15 + r) * NPROJ + 4096 + c4)), (f32x4*)(out + OUT_POOL_P + e * 4)); }
    for (size_t e = gtid; e < (size_t)NBATCH * 3 * 768; e += gsz) { const int c4 = (int)(e % 768) * 4, r = (int)((e / 768) % 3), b = (int)(e / (3 * 768));
        __builtin_nontemporal_store(bf4_to_f32(*(const u32x2*)(PROJ + ((size_t)b * SEQ + SEQ - 3 + r) * NPROJ + c4)), (f32x4*)(out + OUT_CONV_P + e * 4)); }
    for (size_t e = gtid; e < (size_t)MS * 15 * 256; e += gsz) { const int c4 = (int)(e & 255) * 4, r = (int)((e >> 8) % 15), b = (int)(e / (15 * 256));
        __builtin_nontemporal_store((r < 14) ? __builtin_nontemporal_load((const f32x4*)(spool + ((size_t)b * 15 + r + 1) * 1024 + c4)) : bf4_to_f32(*(const u32x2*)(PROJ + (size_t)(MP + b) * NPROJ + 4096 + c4)), (f32x4*)(out + OUT_POOL_S + e * 4)); }
    for (size_t e = gtid; e < (size_t)MS * 3 * 768; e += gsz) { const int c4 = (int)(e % 768) * 4, r = (int)((e / 768) % 3), b = (int)(e / (3 * 768));
        __builtin_nontemporal_store((r < 2) ? __builtin_nontemporal_load((const f32x4*)(sconv + ((size_t)b * 3 + r + 1) * DQKV + c4)) : bf4_to_f32(*(const u32x2*)(PROJ + (size_t)(MP + b) * NPROJ + c4)), (f32x4*)(out + OUT_CONV_S + e * 4)); }
}

__device__ __forceinline__ void gdn_sample(const Args& a, LAS unsigned char* lds) {
    const int tid = otid(), lane = tid & 63, wid = tid >> 6;
    LAS float* qkv = (LAS float*)lds;
    LAS float* sc = qkv + 384;
    LAS float* part = qkv + 512;
    unsigned char* ws = a.ws;
    const bf16_t* PROJ = (const bf16_t*)(ws + WS_PROJ); const float* AB = (const float*)(ws + WS_AB); bf16_t* MIXIN = (bf16_t*)(ws + WS_H);
    const float* sconv = a.in[3]; const float* convw = a.in[7]; const float* S0 = a.in[2];
    float* Sout = a.out + OUT_GDN_S;
    f32x4 sraw[8];
    {   const int e4p = tid & 31, dgp = tid >> 5; const int u0 = blockIdx.x < MS * 8 ? blockIdx.x : 0;
        const float* Sp0 = S0 + ((size_t)u0 * 128 + dgp * 8) * 128 + e4p * 4;
#pragma unroll
        for (int i = 0; i < 8; ++i) sraw[i] = __builtin_nontemporal_load((const f32x4*)(Sp0 + (size_t)i * 128)); }
    float cwp[4], cxp[4]; u32x2 gvp; float avp, bvp;
#define SMP_LOAD(uu) do { const int _u = (uu) < MS * 8 ? (uu) : MS * 8 - 1; const int _b = _u >> 3, _h = _u & 7; const int _t = tid < 384 ? tid : 0; \
        const int _col = (_t >> 7) * 1024 + _h * 128 + (_t & 127); \
        _Pragma("unroll") for (int j = 0; j < 4; ++j) cwp[j] = convw[j * DQKV + _col]; \
        _Pragma("unroll") for (int j = 0; j < 3; ++j) cxp[j] = sconv[((size_t)_b * 3 + j) * DQKV + _col]; \
        cxp[3] = bf1(PROJ[(size_t)(MP + _b) * NPROJ + _col]); \
        gvp = *(const u32x2*)(PROJ + (size_t)(MP + _b) * NPROJ + 3072 + _h * 128 + (tid & 31) * 4); \
        avp = AB[(size_t)(MP + _b) * 16 + _h]; bvp = AB[(size_t)(MP + _b) * 16 + 8 + _h]; } while (0)
    SMP_LOAD((int)blockIdx.x);
    for (int unit = blockIdx.x; unit < MS * 8; unit += gridDim.x) {
        const int b = unit >> 3, h = unit & 7;
        const float ycv = cwp[0] * cxp[0] + cwp[1] * cxp[1] + cwp[2] * cxp[2] + cwp[3] * cxp[3];
        const u32x2 gv = gvp; const float av = avp, bv = bvp;
        SMP_LOAD(unit + (int)gridDim.x);
        if (tid < 384) qkv[tid] = silu_f(ycv);
        __syncthreads();
        if (wid < 2) { const float v0 = qkv[wid * 128 + lane], v1 = qkv[wid * 128 + 64 + lane]; const float ss = wave_sum(v0 * v0 + v1 * v1);
            const float rs = rsqrtf(ss + EPS) * (wid == 0 ? 0.08838834764831845f : 1.0f);
            qkv[wid * 128 + lane] = v0 * rs; qkv[wid * 128 + 64 + lane] = v1 * rs; }
        if (tid == 128) { sc[0] = __expf(-__expf(a.in[8][h]) * softplus_f(av + a.in[9][h])); sc[1] = sigmoid_f(bv); }
        __syncthreads();
        if (wid == 2) { const float d = wave_sum(qkv[lane] * qkv[128 + lane] + qkv[64 + lane] * qkv[192 + lane]); if (lane == 0) sc[2] = d; }
        const int e4 = tid & 31, dg = tid >> 5;
        const float eg = sc[0];
        f32x4 s[8]; f32x4 ks = (f32x4){0.f, 0.f, 0.f, 0.f}, qs = ks;
#pragma unroll
        for (int i = 0; i < 8; ++i) { s[i] = sraw[i] * eg; const float kd = qkv[128 + dg * 8 + i], qd = qkv[dg * 8 + i]; ks += s[i] * kd; qs += s[i] * qd; }
        {   const int nu = unit + (int)gridDim.x < MS * 8 ? unit + (int)gridDim.x : unit;
            const float* Spn = S0 + ((size_t)nu * 128 + dg * 8) * 128 + e4 * 4;
#pragma unroll
            for (int i = 0; i < 8; ++i) sraw[i] = __builtin_nontemporal_load((const f32x4*)(Spn + (size_t)i * 128)); }
        *(LAS f32x4*)(part + dg * 128 + e4 * 4) = ks; *(LAS f32x4*)(part + 2048 + dg * 128 + e4 * 4) = qs;
        __syncthreads();
        f32x4 kst = (f32x4){0.f, 0.f, 0.f, 0.f}, qst = kst;
#pragma unroll
        for (int g = 0; g < 16; ++g) { kst += *(const LAS f32x4*)(part + g * 128 + e4 * 4); qst += *(const LAS f32x4*)(part + 2048 + g * 128 + e4 * 4); }
        const f32x4 vv = *(const LAS f32x4*)(qkv + 256 + e4 * 4);
        const f32x4 delta = (vv - kst) * sc[1];
        float* So = Sout + ((size_t)unit * 128 + dg * 8) * 128 + e4 * 4;
#pragma unroll
        for (int i = 0; i < 8; ++i) __builtin_nontemporal_store(s[i] + delta * qkv[128 + dg * 8 + i], (f32x4*)(So + (size_t)i * 128));
        if (tid < 32) {
            const f32x4 o = qst + delta * sc[2];
            float ss = o[0] * o[0] + o[1] * o[1] + o[2] * o[2] + o[3] * o[3];
#pragma unroll
            for (int off = 16; off >= 1; off >>= 1) ss += __shfl_xor(ss, off);
            const float rs = rsqrtf(ss * (1.0f / 128.0f) + EPS);
            const f32x4 wn = *(const f32x4*)(a.in[10] + e4 * 4);
            u32x2 ov; ov.x = cvt_pk_bf16(o[0] * rs * wn[0] * silu_f(bf_lo(gv.x)), o[1] * rs * wn[1] * silu_f(bf_hi(gv.x)));
            ov.y = cvt_pk_bf16(o[2] * rs * wn[2] * silu_f(bf_lo(gv.y)), o[3] * rs * wn[3] * silu_f(bf_hi(gv.y)));
            *(u32x2*)(MIXIN + (size_t)(MP + b) * DM + h * 128 + e4 * 4) = ov;
        }
        __syncthreads();
    }
#undef SMP_LOAD
}

__device__ __forceinline__ void gdn_scan(const Args& a, LAS unsigned char* lds, int cblk) {
    const int tid = otid(), w = __builtin_amdgcn_readfirstlane(tid >> 6), lane = tid & 63, fr = lane & 15, fq = lane >> 4;
    const bool isV = w < 4; const int mt = w & 3;
    LAS unsigned char* St = lds; LAS unsigned char* Vt = lds + 4352;
    unsigned char* ws = a.ws;
    const float* GL = (const float*)(ws + WS_GL);
    float* O = a.out + OUT_Y;
    for (int blk = cblk; blk < 256; blk += gridDim.x) {
        const int bh = (blk & 7) * 4 + (blk >> 6), es = (blk >> 3) & 7, unit = bh * 8 + es;
        for (int i = tid; i < 4352 / 4; i += 512) ((LAS unsigned*)St)[i] = 0u;
        f32x4 Sacc = (f32x4){0.f, 0.f, 0.f, 0.f};
        const unsigned char* pA = ws + (isV ? WS_W : WS_QG) + ((size_t)bh * 32 * 8192 + (mt * 4 * 64 + lane) * 8) * 2;
        const unsigned char* pX = isV ? ws + WS_U + ((size_t)bh * 32 * 8192 + es * 1024 + mt * 256 + lane * 4) * 4
                                      : ws + WS_INTRA + ((size_t)bh * 32 * 4096 + (mt * 2 * 64 + lane) * 8) * 2;
        const size_t sX = isV ? 32768 : 8192; const int dX = isV ? 0 : 1024;
        const unsigned char* pK = ws + WS_KDT + ((size_t)bh * 32 * 8192 + (w * 2 * 64 + lane) * 8) * 2;
        bf16x8 af[4][4], xf[4][2], kf[4][2]; float gl[4];
#define SCAN_LOAD(s, nn) do { const int cn = (nn) < 32 ? (nn) : 31; \
            _Pragma("unroll") for (int ks = 0; ks < 4; ++ks) af[s][ks] = *(const bf16x8*)(pA + (size_t)cn * 16384 + ks * 1024); \
            xf[s][0] = *(const bf16x8*)(pX + (size_t)cn * sX); xf[s][1] = *(const bf16x8*)(pX + (size_t)cn * sX + dX); \
            _Pragma("unroll") for (int ks = 0; ks < 2; ++ks) kf[s][ks] = *(const bf16x8*)(pK + (size_t)cn * 16384 + ks * 1024); \
            gl[s] = GL[bh * 32 + cn]; } while (0)
        SCAN_LOAD(0, 0); SCAN_LOAD(1, 1); SCAN_LOAD(2, 2);
        __syncthreads();
        for (int g = 0; g < 8; ++g) {
#pragma unroll
            for (int j = 0; j < 4; ++j) {
                const int n = g * 4 + j;
                SCAN_LOAD((j + 3) % 4, n + 3);
                f32x4 acc0 = (f32x4){0.f, 0.f, 0.f, 0.f};
#pragma unroll
                for (int ks = 0; ks < 4; ++ks) { const bf16x8 sf = *(const LAS bf16x8*)(St + fr * 272 + ks * 64 + fq * 16);
                    acc0 = __builtin_amdgcn_mfma_f32_16x16x32_bf16(af[j][ks], sf, acc0, 0, 0, 0); }
                if (isV) {
                    const f32x4 vn = __builtin_bit_cast(f32x4, xf[j][0]) - acc0;
                    u32x2 pk; pk.x = cvt_pk_bf16(vn[0], vn[1]); pk.y = cvt_pk_bf16(vn[2], vn[3]);
                    *(LAS u32x2*)(Vt + fr * 144 + (mt * 16 + fq * 4) * 2) = pk;
                }
                __syncthreads();
                bf16x8 vf[2];
#pragma unroll
                for (int ks = 0; ks < 2; ++ks) vf[ks] = *(const LAS bf16x8*)(Vt + fr * 144 + ks * 64 + fq * 16);
                if (!isV) {
#pragma unroll
                    for (int ks = 0; ks < 2; ++ks) acc0 = __builtin_amdgcn_mfma_f32_16x16x32_bf16(xf[j][ks], vf[ks], acc0, 0, 0, 0);
#pragma unroll
                    for (int r = 0; r < 4; ++r) O[((size_t)unit * SEQ + n * 64 + mt * 16 + fq * 4 + r) * 16 + fr] = acc0[r];
                }
                Sacc *= gl[j];
#pragma unroll
                for (int ks = 0; ks < 2; ++ks) Sacc = __builtin_amdgcn_mfma_f32_16x16x32_bf16(kf[j][ks], vf[ks], Sacc, 0, 0, 0);
                { u32x2 pk; pk.x = cvt_pk_bf16(Sacc[0], Sacc[1]); pk.y = cvt_pk_bf16(Sacc[2], Sacc[3]); *(LAS u32x2*)(St + fr * 272 + (w * 16 + fq * 4) * 2) = pk; }
                __syncthreads();
            }
        }
#undef SCAN_LOAD
        float* Sp = (float*)(ws + WS_SS) + ((size_t)unit * 128 + w * 16 + fq * 4) * 16 + fr;
#pragma unroll
        for (int r = 0; r < 4; ++r) Sp[(size_t)r * 16] = Sacc[r];
        __syncthreads();
    }
}

__device__ __forceinline__ void gated_norm(const Args& a) {
    const int tidr = otid(), lane = tidr & 63, gw = blockIdx.x * 8 + (tidr >> 6), nw = gridDim.x * 8;
    const float* O = a.out + OUT_Y; const bf16_t* PROJ = (const bf16_t*)(a.ws + WS_PROJ); bf16_t* MIXIN = (bf16_t*)(a.ws + WS_H);
    const f32x2 wn = *(const f32x2*)(a.in[10] + 2 * lane);
    f32x2 on[4]; unsigned gn[4];
#define GN_LOAD(it0) do { const int _i0 = (it0) < MP * 8 ? (it0) : MP * 8 - 4; const int _t = _i0 >> 3, _h0 = _i0 & 7; \
        _Pragma("unroll") for (int k = 0; k < 4; ++k) { const int h = _h0 + k; \
            on[k] = __builtin_nontemporal_load((const f32x2*)(O + ((size_t)(((_t >> 11) * 8 + h) * 8 + (lane >> 3)) * SEQ + (_t & (SEQ - 1))) * 16 + ((2 * lane) & 15))); \
            gn[k] = __builtin_nontemporal_load((const unsigned*)(PROJ + (size_t)_t * NPROJ + 3072 + h * 128 + 2 * lane)); } } while (0)
    GN_LOAD(gw * 4);
    for (int item0 = gw * 4; item0 < MP * 8; item0 += nw * 4) {
        const int t = item0 >> 3, h0 = item0 & 7;
        f32x2 o[4]; unsigned gv[4];
#pragma unroll
        for (int k = 0; k < 4; ++k) { o[k] = on[k]; gv[k] = gn[k]; }
        GN_LOAD(item0 + nw * 4);
#pragma unroll
        for (int k = 0; k < 4; ++k) { const int h = h0 + k;
            const float ss = wave_sum(o[k][0] * o[k][0] + o[k][1] * o[k][1]);
            const float rs = rsqrtf(ss * (1.0f / 128.0f) + EPS);
            *(unsigned*)(MIXIN + (size_t)t * DM + h * 128 + 2 * lane) = cvt_pk_bf16(o[k][0] * rs * wn[0] * silu_f(bf_lo(gv[k])), o[k][1] * rs * wn[1] * silu_f(bf_hi(gv[k]))); }
    }
#undef GN_LOAD
}
__device__ __forceinline__ void copy_final_state(const Args& a) {
    const float* SS = (const float*)(a.ws + WS_SS); float* out = a.out + OUT_GDN_P;
    const size_t gtid = (size_t)blockIdx.x * 512 + otid(), gsz = (size_t)gridDim.x * 512;
    for (size_t e4 = gtid; e4 < (size_t)32 * 128 * 32; e4 += gsz) { const int ee = (int)(e4 & 31) * 4, d = (int)((e4 >> 5) & 127), bh = (int)(e4 >> 12);
        __builtin_nontemporal_store(__builtin_nontemporal_load((const f32x4*)(SS + ((size_t)(bh * 8 + (ee >> 4)) * 128 + d) * 16 + (ee & 15))), (f32x4*)(out + e4 * 4)); }
}

__device__ __forceinline__ void load_row_bf16_or_partials(f32x4 (&v)[8], const bf16_t* B, const float* P, int ks, int row, int lane) {
    if (row < MP) {
#pragma unroll
        for (int i = 0; i < 8; ++i) { const u32x2 u = *(const u32x2*)(B + (size_t)row * DM + (i * 64 + lane) * 4); v[i] = (f32x4){bf_lo(u.x), bf_hi(u.x), bf_lo(u.y), bf_hi(u.y)}; }
    } else {
#pragma unroll
        for (int i = 0; i < 8; ++i) v[i] = (f32x4){0.f, 0.f, 0.f, 0.f};
#pragma unroll 4
        for (int p = 0; p < ks; ++p) { const float* pp = P + ((size_t)p * 128 + (row - MP)) * DM + lane * 4;
#pragma unroll
            for (int i = 0; i < 8; ++i) v[i] += *(const f32x4*)(pp + i * 256); }
    }
}
__device__ __forceinline__ void row_phase_mid(const Args& a) {
    const int tidr = otid(), lane = tidr & 63, gw = blockIdx.x * 8 + (tidr >> 6), nw = gridDim.x * 8;
    const bf16_t* MIX = (const bf16_t*)(a.ws + WS_MIX); bf16_t* HM = (bf16_t*)(a.ws + WS_H); bf16_t* X1 = (bf16_t*)(a.ws + WS_X1);
    const float* w1 = a.in[14]; const float* w2 = a.in[15];
    u32x2 raw[8];
#pragma unroll
    for (int i = 0; i < 8; ++i) raw[i] = *(const u32x2*)(MIX + (size_t)(gw < MP ? gw : 0) * DM + (i * 64 + lane) * 4);
    for (int row = gw; row < MT; row += nw) {
        const float* x = row < MP ? a.in[0] + (size_t)row * DM : a.in[1] + (size_t)(row - MP) * DM;
        f32x4 v[8]; float ss = 0.f;
        if (row < MP) {
#pragma unroll
            for (int i = 0; i < 8; ++i) v[i] = (f32x4){bf_lo(raw[i].x), bf_hi(raw[i].x), bf_lo(raw[i].y), bf_hi(raw[i].y)};
        } else load_row_bf16_or_partials(v, MIX, (const float*)(a.ws + WS_PART5), KS5, row, lane);
        {   const int nr = (row + nw < MP) ? row + nw : MP - 1;
#pragma unroll
            for (int i = 0; i < 8; ++i) raw[i] = __builtin_nontemporal_load((const u32x2*)(MIX + (size_t)nr * DM + (i * 64 + lane) * 4)); }
#pragma unroll
        for (int i = 0; i < 8; ++i) ss += v[i][0] * v[i][0] + v[i][1] * v[i][1] + v[i][2] * v[i][2] + v[i][3] * v[i][3];
        ss = wave_sum(ss);
        const float rs = rsqrtf(ss * (1.0f / DM) + EPS);
        float ss2 = 0.f;
#pragma unroll
        for (int i = 0; i < 8; ++i) { const f32x4 xv = __builtin_nontemporal_load((const f32x4*)(x + (i * 64 + lane) * 4)), w = *(const f32x4*)(w1 + (i * 64 + lane) * 4);
            v[i] = xv + v[i] * rs * w; ss2 += v[i][0] * v[i][0] + v[i][1] * v[i][1] + v[i][2] * v[i][2] + v[i][3] * v[i][3];
            u32x2 o; o.x = cvt_pk_bf16(v[i][0], v[i][1]); o.y = cvt_pk_bf16(v[i][2], v[i][3]);
            __builtin_nontemporal_store(o, (u32x2*)(X1 + (size_t)row * DM + (i * 64 + lane) * 4)); }
        ss2 = wave_sum(ss2);
        const float rs2 = rsqrtf(ss2 * (1.0f / DM) + EPS);
#pragma unroll
        for (int i = 0; i < 8; ++i) { const f32x4 w = *(const f32x4*)(w2 + (i * 64 + lane) * 4);
            u32x2 o; o.x = cvt_pk_bf16(v[i][0] * rs2 * w[0], v[i][1] * rs2 * w[1]); o.y = cvt_pk_bf16(v[i][2] * rs2 * w[2], v[i][3] * rs2 * w[3]);
            *(u32x2*)(HM + (size_t)row * DM + (i * 64 + lane) * 4) = o; }
    }
}
__device__ __forceinline__ void row_phase_final(const Args& a) {
    const int tidr = otid(), lane = tidr & 63, gw = blockIdx.x * 8 + (tidr >> 6), nw = gridDim.x * 8;
    const bf16_t* FF = (const bf16_t*)(a.ws + WS_FF); const bf16_t* X1 = (const bf16_t*)(a.ws + WS_X1); float* Y = a.out + OUT_Y; const float* w1 = a.in[18];
    u32x2 raw[8];
#pragma unroll
    for (int i = 0; i < 8; ++i) raw[i] = *(const u32x2*)(FF + (size_t)(gw < MP ? gw : 0) * DM + (i * 64 + lane) * 4);
    for (int row = gw; row < MT; row += nw) {
        f32x4 v[8]; float ss = 0.f;
        if (row < MP) {
#pragma unroll
            for (int i = 0; i < 8; ++i) v[i] = (f32x4){bf_lo(raw[i].x), bf_hi(raw[i].x), bf_lo(raw[i].y), bf_hi(raw[i].y)};
        } else load_row_bf16_or_partials(v, FF, (const float*)(a.ws + WS_PART8), KS8, row, lane);
        {   const int nr = (row + nw < MP) ? row + nw : MP - 1;
#pragma unroll
            for (int i = 0; i < 8; ++i) raw[i] = __builtin_nontemporal_load((const u32x2*)(FF + (size_t)nr * DM + (i * 64 + lane) * 4)); }
#pragma unroll
        for (int i = 0; i < 8; ++i) ss += v[i][0] * v[i][0] + v[i][1] * v[i][1] + v[i][2] * v[i][2] + v[i][3] * v[i][3];
        ss = wave_sum(ss);
        const float rs = rsqrtf(ss * (1.0f / DM) + EPS);
#pragma unroll
        for (int i = 0; i < 8; ++i) { const u32x2 u = __builtin_nontemporal_load((const u32x2*)(X1 + (size_t)row * DM + (i * 64 + lane) * 4)); const f32x4 xv = (f32x4){bf_lo(u.x), bf_hi(u.x), bf_lo(u.y), bf_hi(u.y)}, w = *(const f32x4*)(w1 + (i * 64 + lane) * 4);
            __builtin_nontemporal_store(xv + v[i] * rs * w, (f32x4*)(Y + (size_t)row * DM + (i * 64 + lane) * 4)); }
    }
}

#define XB_TMO      128
#define XB_XCNT(j)  (256  + 64 * (j))
#define XB_XSUB(j)  (1280 + 64 * (j))
#define XB_XGEN(j)  (2304 + 64 * (j))
#define XB_TOP      3328
#define XB_TOPGEN   3392
#define XCD_BAR_WORDS 3456
#define XB_SPIN_CAP (1u << 18)
__device__ __forceinline__ unsigned xb_ld(unsigned* p)              { return __hip_atomic_load(p, __ATOMIC_RELAXED, __HIP_MEMORY_SCOPE_AGENT); }
__device__ __forceinline__ unsigned xb_add(unsigned* p, unsigned v) { return __hip_atomic_fetch_add(p, v, __ATOMIC_RELAXED, __HIP_MEMORY_SCOPE_AGENT); }
__device__ __forceinline__ unsigned xb_xcc_id() { return (unsigned)__builtin_amdgcn_s_getreg((3 << 11) | 20) & 0xFu; }
#define XB_SPIN(cond, bar) do { unsigned _sp = 0; while (cond) { __builtin_amdgcn_s_sleep(1); \
    if ((++_sp & 255u) == 0u) { if (xb_ld(&(bar)[XB_TMO])) break; if (_sp > XB_SPIN_CAP) { atomicAdd(&(bar)[XB_TMO], 1u); break; } } } } while (0)
struct XcdBarrier { unsigned* bar; unsigned x; volatile LAS unsigned* st; };
__device__ __forceinline__ XcdBarrier xcd_barrier_post(unsigned* bar, volatile LAS unsigned* st) {
    XcdBarrier b; b.bar = bar; b.x = xb_xcc_id(); b.st = st;
    if (threadIdx.x == 0) st[2] = xb_add(&bar[XB_XCNT(b.x)], 1u);
    return b;
}
__device__ __forceinline__ void xcd_barrier_complete(unsigned* bar, unsigned x, unsigned& nloc, unsigned& nx) {
    const unsigned G = gridDim.x * gridDim.y * gridDim.z;
    unsigned sum, cnt, mine, sp = 0u;
    for (;;) {
        sum = 0u; cnt = 0u; mine = 0u;
#pragma unroll
        for (unsigned j = 0; j < 16; ++j) { const unsigned c = xb_ld(&bar[XB_XCNT(j)]); sum += c; cnt += (c > 0u) ? 1u : 0u; mine = (j == x) ? c : mine; }
        if (sum == G) break;
        __builtin_amdgcn_s_sleep(1);
        if ((++sp & 255u) == 0u) { if (xb_ld(&bar[XB_TMO])) break; if (sp > XB_SPIN_CAP) { atomicAdd(&bar[XB_TMO], 1u); break; } }
    }
    nloc = mine > 0u ? mine : 1u; nx = cnt > 0u ? cnt : 1u;
}
__device__ __forceinline__ void xcd_barrier(const XcdBarrier& b) {
    asm volatile("s_waitcnt vmcnt(0)" ::: "memory");
    __syncthreads();
    if (threadIdx.x == 0) {
        unsigned* bar = b.bar;
        __builtin_amdgcn_s_waitcnt(0);
        unsigned nloc = b.st[0], nx = b.st[1];
        if (nloc == 0u) { xcd_barrier_complete(bar, b.x, nloc, nx); b.st[0] = nloc; b.st[1] = nx; }
        const unsigned old = xb_add(&bar[XB_XSUB(b.x)], 1u);
        const unsigned gen = old / nloc;
        if (old + 1u == (gen + 1u) * nloc) {
            __builtin_amdgcn_fence(__ATOMIC_RELEASE, "agent");
            asm volatile("s_waitcnt vmcnt(0)" ::: "memory");
            const unsigned og = xb_add(&bar[XB_TOP], 1u);
            const unsigned tg = og / nx;
            if (og + 1u == (tg + 1u) * nx) xb_add(&bar[XB_TOPGEN], 1u);
            else XB_SPIN(xb_ld(&bar[XB_TOPGEN]) == tg, bar);
            __builtin_amdgcn_fence(__ATOMIC_ACQUIRE, "agent");
            xb_add(&bar[XB_XGEN(b.x)], 1u);
            asm volatile("s_waitcnt vmcnt(0)" ::: "memory");
        } else {
            XB_SPIN(xb_ld(&bar[XB_XGEN(b.x)]) == gen, bar);
            __builtin_amdgcn_fence(__ATOMIC_ACQUIRE, "agent");
            asm volatile("s_waitcnt vmcnt(0)" ::: "memory");
        }
    }
    __syncthreads();
}

__device__ __forceinline__ void grid_sync(cg::grid_group& grid) {
    asm volatile("s_waitcnt vmcnt(0) lgkmcnt(0)" ::: "memory");
    grid.sync();
    __builtin_amdgcn_fence(__ATOMIC_ACQUIRE, "agent");
    asm volatile("s_waitcnt vmcnt(0)" ::: "memory");
}

#ifdef STOPK
__device__ __forceinline__ void probe_dump(const Args& a, int which) {
    const size_t gtid = (size_t)blockIdx.x * 512 + otid(), gsz = (size_t)gridDim.x * 512;
    const bf16_t* src = (const bf16_t*)(a.ws + ((which == 1 || which == 5) ? WS_PROJ : which == 2 ? WS_QG : WS_H));
    if (which == 5) {
        const float* ab = (const float*)(a.ws + WS_AB);
        for (size_t e = gtid; e < 37584896; e += gsz) a.out[e] = (e < 16777216) ? bf1(src[(size_t)MPAD * NPROJ - 1 - e * 2]) : (e < 16777216 + (size_t)MPAD * 16 ? ab[e - 16777216] : 0.f);
        return; }
    if (which == 2) { for (size_t e = gtid; e < 37584896; e += gsz) a.out[e] = (e < 8388608) ? ((const float*)(a.ws + WS_U))[e] : (e < 8388608 + 1024 ? ((const float*)(a.ws + WS_GL))[e - 8388608] : 0.f); return; }
    for (size_t e = gtid; e < 37584896; e += gsz) a.out[e] = (e < 16777216) ? bf1(src[e * 2]) : 0.f;
}
#endif
__global__ __launch_bounds__(512, 2) void fwd_megakernel(Args a) {
    extern __shared__ __attribute__((aligned(16))) unsigned char shm[];
    LAS unsigned char* lds = (LAS unsigned char*)shm;
    cg::grid_group grid = cg::this_grid();
    unsigned char* ws = a.ws;
    StaticOrder S;
    volatile LAS unsigned* bst = (volatile LAS unsigned*)(lds + LDS_BYTES - 16);
    if (threadIdx.x < 4) bst[threadIdx.x] = 0u;
    __syncthreads();
    const XcdBarrier xbar = xcd_barrier_post((unsigned*)(ws + WS_BAR), bst);

    if (a.ws == nullptr) grid_sync(grid);
    phase0(a, lds);
    xcd_barrier(xbar);
    const unsigned crk = bst[2];
    bool even = xbar.x < 8u;
#pragma unroll
    for (int j = 0; j < 8; ++j) even = even && (xb_ld((unsigned*)(ws + WS_BAR) + XB_XCNT(j)) * 8u == gridDim.x);
    const int cblk = __builtin_amdgcn_readfirstlane((even && crk * 8u < gridDim.x) ? (int)(crk * 8u + xbar.x) : (int)blockIdx.x);
    {
        Gemm g{(const bf16_t*)(ws + WS_H), (const bf16_t*)(ws + WS_WIN), DM, DM, DM, 0, 0};
        EpiProj E{(bf16_t*)(ws + WS_PROJ), (float*)(ws + WS_AB)};
        S.init(MPAD, NPADW, gridDim.x, cblk, DM);
        gemm_phase(lds, g, S, E);
        convert_on_idle(a, lds, cblk, S.nwg % (int)gridDim.x, TL_WUP, TL_WDN);
#if DOUBLE_PHASE == 18
        gemm_phase(lds, g, S, E);
#endif
    }
    xcd_barrier(xbar);
#if DOUBLE_PHASE == 99
    xcd_barrier(xbar);
#endif
#if defined(STOPK) && STOPK == 1
    probe_dump(a, 5); return;
#endif
    gdn_sample(a, lds);
    pool_and_copies(a);
    gdn_chunk_prep(a, lds);
#if DOUBLE_PHASE == 2
    gdn_chunk_prep(a, lds);
#endif

#if DOUBLE_PHASE == 21
    pool_and_copies(a);
    gdn_sample(a, lds);
#endif
    xcd_barrier(xbar);
#if DOUBLE_PHASE == 99
    xcd_barrier(xbar);
#endif
#if defined(STOPK) && STOPK == 2
    probe_dump(a, 2); return;
#endif
    gdn_scan(a, lds, cblk);
#if DOUBLE_PHASE == 3
    gdn_scan(a, lds, cblk);
#endif
    {
        Gemm g{(const bf16_t*)(ws + WS_POOLED), (const bf16_t*)(ws + WS_WPOOL), 1024, 256, 256, 256, 0};
        EpiBf16<0> E{(bf16_t*)(ws + WS_H), DM, 1024};
        S.init(MPAD, 1024, gridDim.x, cblk, 256);
        gemm_phase(lds, g, S, E);
        convert_on_idle(a, lds, cblk, S.nwg % (int)gridDim.x, TL_WOUT, TL_WUP);
    }
    xcd_barrier(xbar);
#if DOUBLE_PHASE == 99
    xcd_barrier(xbar);
#endif
#if defined(STOPK) && STOPK == 3
    { const size_t gtid = (size_t)blockIdx.x * 512 + otid(), gsz = (size_t)gridDim.x * 512;
      for (size_t e = gtid + PROBE3_KEEP; e < 37584896; e += gsz) a.out[e] = 0.f; return; }
#endif
    gated_norm(a);
    copy_final_state(a);
#if DOUBLE_PHASE == 4
    gated_norm(a);
#endif
    xcd_barrier(xbar);
#if DOUBLE_PHASE == 99
    xcd_barrier(xbar);
#endif
#if defined(STOPK) && STOPK == 4
    probe_dump(a, 4); return;
#endif
    {
        Gemm g{(const bf16_t*)(ws + WS_H), (const bf16_t*)(ws + WS_WOUT), DM, DM, DM, 0, 0};
        EpiBf16P<0> E{(bf16_t*)(ws + WS_MIX), DM, (float*)(ws + WS_PART5)};
        SplitOrder S2; S2.init(DM, gridDim.x, cblk, DM, KS5);
        gemm_phase(lds, g, S2, E);
        convert_on_idle(a, lds, cblk, (S2.m.nwg + S2.nsub) % (int)gridDim.x, TL_WDN, TL_WPOOL);
#if DOUBLE_PHASE == 5
        gemm_phase(lds, g, S, E);
#endif
    }
    xcd_barrier(xbar);
#if DOUBLE_PHASE == 99
    xcd_barrier(xbar);
#endif
    row_phase_mid(a);
#if DOUBLE_PHASE == 4
    row_phase_mid(a);
#endif
    xcd_barrier(xbar);
#if DOUBLE_PHASE == 99
    xcd_barrier(xbar);
#endif
    {
        Gemm g{(const bf16_t*)(ws + WS_H), (const bf16_t*)(ws + WS_WUP), DM, DM, DM, 0, 0};
        EpiBf16P<1, 1> E{(bf16_t*)(ws + WS_FF1), DFF, (float*)(ws + WS_PART7)};
        SplitOrder S2; S2.init(DFF, gridDim.x, cblk, DM, KS7);
        gemm_phase(lds, g, S2, E);
#if DOUBLE_PHASE == 7
        gemm_phase(lds, g, S, E);
#endif
    }
    xcd_barrier(xbar);
#if DOUBLE_PHASE == 99
    xcd_barrier(xbar);
#endif
    {
        const float* P7 = (const float*)(ws + WS_PART7); bf16_t* FF1 = (bf16_t*)(ws + WS_FF1);
        const size_t gtid = (size_t)blockIdx.x * 512 + otid(), gsz = (size_t)gridDim.x * 512;
        for (size_t item = gtid; item < (size_t)MS * (DFF / 8); item += gsz) {
            const int r = (int)(item >> 10), c8 = (int)(item & 1023);
            f32x4 s0 = (f32x4){0.f, 0.f, 0.f, 0.f}, s1 = s0;
#pragma unroll
            for (int p = 0; p < KS7; ++p) { const float* pp = P7 + ((size_t)p * 128 + r) * DFF + c8 * 8; s0 += __builtin_nontemporal_load((const f32x4*)pp); s1 += __builtin_nontemporal_load((const f32x4*)(pp + 4)); }
#pragma unroll
            for (int j = 0; j < 4; ++j) { const float p = fmaxf(s0[j], 0.f), q = fmaxf(s1[j], 0.f); s0[j] = p * p; s1[j] = q * q; }
            u32x4 w; w.x = cvt_pk_bf16(s0[0], s0[1]); w.y = cvt_pk_bf16(s0[2], s0[3]); w.z = cvt_pk_bf16(s1[0], s1[1]); w.w = cvt_pk_bf16(s1[2], s1[3]);
            *(u32x4*)(FF1 + (size_t)(MP / BM) * ((size_t)DFF * BM) + (size_t)(c8 >> 3) * (BM * BK) + (size_t)r * BK + (c8 & 7) * 8) = w;
        }
    }
    xcd_barrier(xbar);
    {
        Gemm g{(const bf16_t*)(ws + WS_FF1), (const bf16_t*)(ws + WS_WDN), BK, BK, DFF, 0, 1};
        EpiBf16P<0> E{(bf16_t*)(ws + WS_FF), DM, (float*)(ws + WS_PART8)};
        SplitOrder S2; S2.init(DM, gridDim.x, cblk, DFF, KS8);
        gemm_phase(lds, g, S2, E);
#if DOUBLE_PHASE == 18
        gemm_phase(lds, g, S2, E);
#endif
    }
    xcd_barrier(xbar);
#if DOUBLE_PHASE == 99
    xcd_barrier(xbar);
#endif
    row_phase_final(a);
}

extern "C" void kernel_launch(void* const* d_in, const int* in_sizes, int n_in, void* d_out, int out_size, void* d_ws, size_t ws_size, hipStream_t stream) {
    static int grid_blocks = 0;
    if (grid_blocks == 0) {
        if (n_in != 19 || ws_size < WS_END) { fprintf(stderr, "kernel_launch: need 19 inputs and >= %zu bytes of workspace (got %d, %zu)\n", (size_t)WS_END, n_in, ws_size); grid_blocks = -1; return; }
        int dev = 0, cus = 0, per_cu = 0;
        hipGetDevice(&dev);
        hipDeviceGetAttribute(&cus, hipDeviceAttributeMultiprocessorCount, dev);
        if (hipFuncSetAttribute((const void*)fwd_megakernel, hipFuncAttributeMaxDynamicSharedMemorySize, LDS_BYTES) != hipSuccess) { fprintf(stderr, "kernel_launch: hipFuncSetAttribute failed\n"); grid_blocks = -1; return; }
        hipOccupancyMaxActiveBlocksPerMultiprocessor(&per_cu, (const void*)fwd_megakernel, 512, LDS_BYTES);
        if (per_cu < 1) { fprintf(stderr, "kernel_launch: occupancy query says %d blocks per CU\n", per_cu); per_cu = 1; }
        (void)hipGetLastError();
        grid_blocks = cus;
    }
    if (grid_blocks < 0) return;
    Args a{};
    for (int i = 0; i < 19; ++i) a.in[i] = (const float*)d_in[i];
    a.out = (float*)d_out; a.ws = (unsigned char*)d_ws;
    (void)hipMemsetAsync((unsigned char*)d_ws + WS_BAR, 0, XCD_BAR_WORDS * 4, stream);
    void* args[] = {&a};
    hipError_t e = hipLaunchCooperativeKernel((const void*)fwd_megakernel, dim3(grid_blocks), dim3(512), args, LDS_BYTES, stream);
    if (e != hipSuccess) fprintf(stderr, "cooperative launch failed: %s (grid %d)\n", hipGetErrorString(e), grid_blocks);
}
```
